# Optimizing an MI355X kernel written in HIP

```python
import math
import jax, jax.numpy as jnp
from jax import lax
import numpy as np

D_MODEL = 2048
BATCH = 2
SEQ = 8192
DEPTH = 1

N_META = 16
GRID_W = 64
DA_HEADS = 8
DA_HEAD_DIM = 64
DA_V_DIM = 2 * DA_HEAD_DIM
DA_Q_BLOCK = 128
DA_QK_W = DA_HEADS * 2 * DA_HEAD_DIM
DA_V_W = DA_HEADS * DA_V_DIM
NA_HEADS = 16
NA_HEAD_DIM = 64
NA_W = NA_HEADS * NA_HEAD_DIM
NA_WIN_H = 8
NA_WIN_W = 16
IN_SPLITS = (DA_QK_W, DA_QK_W, DA_V_W, NA_W, NA_W, NA_W, D_MODEL, D_MODEL)
IN_COLS = sum(IN_SPLITS)
PEER_HEADS = 8
PEER_N_KEYS = 128
PEER_N_EXPERTS = PEER_N_KEYS * PEER_N_KEYS
PEER_KEY_DIM = 256
PEER_TOPK = 16
PEER_CHUNK = 128
EPS = 1e-6

kernel_name = "hybrid_diffattn_natten_peer_block"


def rms_norm(x, g):
    xf = x.astype(jnp.float32)
    y = xf * lax.rsqrt(jnp.mean(xf * xf, axis=-1, keepdims=True) + EPS)
    return (y * g.astype(jnp.float32)).astype(x.dtype)


def alibi_slopes(n_heads):
    return jnp.asarray(2.0 ** (-8.0 * np.arange(1, n_heads + 1) / n_heads), dtype=jnp.float32)


def diff_attention(q, k, v, lam, slopes):
    B, L, H = q.shape[0], q.shape[1], q.shape[2]
    scale = DA_HEAD_DIM ** -0.5
    kpos = jnp.arange(L, dtype=jnp.float32)

    def attend(q_blk, qpos):
        s = jnp.einsum('bqhcd,bkhcd->bchqk', q_blk, k).astype(jnp.float32) * scale
        bias = -slopes[:, None, None] * jnp.abs(qpos[:, None] - kpos[None, :])[None]
        p = jax.nn.softmax(s + bias, axis=-1)
        a = p[:, 0] - lam * p[:, 1]
        return jnp.einsum('bhqk,bkhe->bqhe', a.astype(v.dtype), v)

    meta_out = attend(q[:, :N_META], jnp.arange(N_META, dtype=jnp.float32))
    n_real = L - N_META
    nb = n_real // DA_Q_BLOCK
    q_real = q[:, N_META:].reshape(B, nb, DA_Q_BLOCK, H, 2, DA_HEAD_DIM).transpose(1, 0, 2, 3, 4, 5)
    qpos_real = (N_META + jnp.arange(n_real, dtype=jnp.float32)).reshape(nb, DA_Q_BLOCK)
    real_out = lax.map(lambda args: attend(args[0], args[1]), (q_real, qpos_real))
    real_out = real_out.transpose(1, 0, 2, 3, 4).reshape(B, n_real, H, DA_V_DIM)
    return jnp.concatenate([meta_out, real_out], axis=1)


def neighbourhood_attention(q, k, v, rpb):
    B, L, H, dh = q.shape
    n_real = L - N_META
    rows = n_real // GRID_W
    kh = min(NA_WIN_H, rows)
    kw = NA_WIN_W
    scale = dh ** -0.5
    qm, km, vm = q[:, :N_META], k[:, :N_META], v[:, :N_META]
    sm = jnp.einsum('bqhd,bmhd->bhqm', qm, km).astype(jnp.float32) * scale
    meta_out = jnp.einsum('bhqm,bmhd->bqhd', jax.nn.softmax(sm, axis=-1).astype(v.dtype), vm)

    qg = q[:, N_META:].reshape(B, rows, GRID_W, H, dh)
    kg = k[:, N_META:].reshape(B, rows, GRID_W, H, dh)
    vg = v[:, N_META:].reshape(B, rows, GRID_W, H, dh)
    cols = jnp.arange(GRID_W)
    col_start = jnp.clip(cols - kw // 2, 0, GRID_W - kw)
    col_idx = col_start[:, None] + jnp.arange(kw)[None, :]
    dc_idx = col_idx - cols[:, None] + (NA_WIN_W - 1)

    def attend_row(args):
        q_row, r = args
        r0 = jnp.clip(r - kh // 2, 0, rows - kh)
        k_rows = lax.dynamic_slice_in_dim(kg, r0, kh, axis=1)
        v_rows = lax.dynamic_slice_in_dim(vg, r0, kh, axis=1)
        k_nb = k_rows[:, :, col_idx]
        v_nb = v_rows[:, :, col_idx]
        s_win = jnp.einsum('bqhd,bjqwhd->bhqjw', q_row, k_nb).astype(jnp.float32) * scale
        dr_idx = r0 + jnp.arange(kh) - r + (NA_WIN_H - 1)
        bias = rpb[:, dr_idx[None, :, None], dc_idx[:, None, :]]
        s_win = s_win + bias.astype(jnp.float32)[None]
        s_meta = jnp.einsum('bqhd,bmhd->bhqm', q_row, km).astype(jnp.float32) * scale
        s = jnp.concatenate([s_win.reshape(B, H, GRID_W, kh * kw), s_meta], axis=-1)
        p = jax.nn.softmax(s, axis=-1).astype(v.dtype)
        p_win = p[..., :kh * kw].reshape(B, H, GRID_W, kh, kw)
        p_meta = p[..., kh * kw:]
        return (jnp.einsum('bhqjw,bjqwhd->bqhd', p_win, v_nb)
                + jnp.einsum('bhqm,bmhd->bqhd', p_meta, vm))

    out = lax.map(attend_row, (qg.transpose(1, 0, 2, 3, 4), jnp.arange(rows)))
    out = out.transpose(1, 0, 2, 3, 4).reshape(B, n_real, H, dh)
    return jnp.concatenate([meta_out, out], axis=1)


def peer_ffn(x, w_query, sub_keys, expert_u, expert_v):
    B, L, D = x.shape
    T = B * L
    n_chunks = -(-T // PEER_CHUNK)
    pad = n_chunks * PEER_CHUNK - T
    xt = jnp.pad(x.reshape(T, D), ((0, pad), (0, 0))).reshape(n_chunks, PEER_CHUNK, D)

    def chunk(xc):
        q = (xc @ w_query).reshape(PEER_CHUNK, PEER_HEADS, 2, PEER_KEY_DIM // 2)
        s = jnp.einsum('chpk,pnk->chpn', q, sub_keys).astype(jnp.float32)
        s1, i1 = lax.top_k(s[:, :, 0], PEER_TOPK)
        s2, i2 = lax.top_k(s[:, :, 1], PEER_TOPK)
        cand = (s1[..., :, None] + s2[..., None, :]).reshape(PEER_CHUNK, PEER_HEADS, PEER_TOPK * PEER_TOPK)
        sc, ci = lax.top_k(cand, PEER_TOPK)
        e = (jnp.take_along_axis(i1, ci // PEER_TOPK, axis=-1) * PEER_N_KEYS
             + jnp.take_along_axis(i2, ci % PEER_TOPK, axis=-1))
        g = jax.nn.softmax(sc, axis=-1)
        u = expert_u[e]
        v = expert_v[e]
        a = jax.nn.gelu(jnp.einsum('cd,chkd->chk', xc, u).astype(jnp.float32))
        return jnp.einsum('chk,chkd->cd', (g * a).astype(xc.dtype), v)

    out = lax.map(chunk, xt).reshape(n_chunks * PEER_CHUNK, D)[:T]
    return out.reshape(B, L, D)


def setup_inputs(seed: int = 0) -> dict:
    key = jax.random.key(seed)
    ks = jax.random.split(key, 24)
    f32 = jnp.float32
    nrm = lambda k, shape, s: jax.random.normal(k, shape, f32) * s
    gain = lambda k, shape: 1.0 + 0.01 * jax.random.normal(k, shape, f32)
    return {
        'x': nrm(ks[0], (BATCH, SEQ, D_MODEL), 1.0),
        'meta_tokens': nrm(ks[1], (N_META, D_MODEL), 1.0),
        'norm1_g': gain(ks[2], (DEPTH, D_MODEL)),
        'w_in': nrm(ks[3], (DEPTH, D_MODEL, IN_COLS), D_MODEL ** -0.5),
        'da_q_norm_g': gain(ks[4], (DEPTH, DA_HEAD_DIM)),
        'da_k_norm_g': gain(ks[5], (DEPTH, DA_HEAD_DIM)),
        'lambda_q1': nrm(ks[6], (DEPTH, DA_HEAD_DIM), 0.1),
        'lambda_k1': nrm(ks[7], (DEPTH, DA_HEAD_DIM), 0.1),
        'lambda_q2': nrm(ks[8], (DEPTH, DA_HEAD_DIM), 0.1),
        'lambda_k2': nrm(ks[9], (DEPTH, DA_HEAD_DIM), 0.1),
        'da_out_norm_g': gain(ks[10], (DEPTH, DA_V_DIM)),
        'na_q_norm_g': gain(ks[11], (DEPTH, NA_HEAD_DIM)),
        'na_k_norm_g': gain(ks[12], (DEPTH, NA_HEAD_DIM)),
        'na_rpb': nrm(ks[13], (DEPTH, NA_HEADS, 2 * NA_WIN_H - 1, 2 * NA_WIN_W - 1), 0.1),
        'w_branch_da': nrm(ks[14], (DEPTH, DA_V_W, D_MODEL), DA_V_W ** -0.5),
        'w_branch_na': nrm(ks[15], (DEPTH, NA_W, D_MODEL), NA_W ** -0.5),
        'w_out': nrm(ks[16], (DEPTH, D_MODEL, D_MODEL), D_MODEL ** -0.5),
        'norm2_g': gain(ks[17], (DEPTH, D_MODEL)),
        'peer_w_query': nrm(ks[18], (DEPTH, D_MODEL, PEER_HEADS * PEER_KEY_DIM), D_MODEL ** -0.5),
        'peer_sub_keys': nrm(ks[19], (DEPTH, 2, PEER_N_KEYS, PEER_KEY_DIM // 2), (PEER_KEY_DIM // 2) ** -0.5),
        'peer_u': nrm(ks[20], (DEPTH, PEER_N_EXPERTS, D_MODEL), D_MODEL ** -0.5),
        'peer_v': nrm(ks[21], (DEPTH, PEER_N_EXPERTS, D_MODEL), 0.5),
    }


def reference(x, meta_tokens, norm1_g, w_in, da_q_norm_g, da_k_norm_g, lambda_q1, lambda_k1,
              lambda_q2, lambda_k2, da_out_norm_g, na_q_norm_g, na_k_norm_g, na_rpb,
              w_branch_da, w_branch_na, w_out, norm2_g, peer_w_query, peer_sub_keys, peer_u, peer_v):
    B, S, D = x.shape
    L = S + N_META
    meta = jnp.broadcast_to(meta_tokens[None].astype(x.dtype), (B, N_META, D))
    h = jnp.concatenate([meta, x], axis=1)
    slopes = alibi_slopes(DA_HEADS)
    split_pts = [int(c) for c in np.cumsum(IN_SPLITS)[:-1]]
    for l in range(DEPTH):
        xn = rms_norm(h, norm1_g[l])
        proj = xn @ w_in[l]
        q_da, k_da, v_da, q_na, k_na, v_na, gate_da, gate_na = jnp.split(proj, split_pts, axis=-1)

        q_da = rms_norm(q_da.reshape(B, L, DA_HEADS, 2, DA_HEAD_DIM), da_q_norm_g[l])
        k_da = rms_norm(k_da.reshape(B, L, DA_HEADS, 2, DA_HEAD_DIM), da_k_norm_g[l])
        v_da = v_da.reshape(B, L, DA_HEADS, DA_V_DIM)
        lam_init = 0.8 - 0.6 * math.exp(-0.3 * l)
        lam = (jnp.exp(jnp.sum(lambda_q1[l].astype(jnp.float32) * lambda_k1[l].astype(jnp.float32)))
               - jnp.exp(jnp.sum(lambda_q2[l].astype(jnp.float32) * lambda_k2[l].astype(jnp.float32)))
               + lam_init)
        o_da = diff_attention(q_da, k_da, v_da, lam, slopes)
        o_da = rms_norm(o_da, da_out_norm_g[l]) * (1.0 - lam_init)
        y_da = o_da.reshape(B, L, DA_V_W) @ w_branch_da[l]

        q_na = rms_norm(q_na.reshape(B, L, NA_HEADS, NA_HEAD_DIM), na_q_norm_g[l])
        k_na = rms_norm(k_na.reshape(B, L, NA_HEADS, NA_HEAD_DIM), na_k_norm_g[l])
        v_na = v_na.reshape(B, L, NA_HEADS, NA_HEAD_DIM)
        o_na = neighbourhood_attention(q_na, k_na, v_na, na_rpb[l])
        y_na = o_na.reshape(B, L, NA_W) @ w_branch_na[l]

        mixed = jax.nn.sigmoid(gate_da) * y_da + jax.nn.sigmoid(gate_na) * y_na
        h = h + mixed @ w_out[l]

        h = h + peer_ffn(rms_norm(h, norm2_g[l]), peer_w_query[l], peer_sub_keys[l], peer_u[l], peer_v[l])
    return h[:, N_META:]
```

```cpp
#include <hip/hip_runtime.h>
#include <cstdio>
#include <cstdint>

constexpr int BATCH = 2, SEQ = 8192, DM = 2048, M = BATCH * SEQ, NMETA = 16;
constexpr int INCOLS = 10240;
constexpr float EPS = 1e-6f;
constexpr float QSCALE = 0.125f * 1.4426950408889634f;
constexpr float LOG2E = 1.4426950408889634f;
constexpr float NEGBIG = -1.0e30f;

namespace pg8 {
#define PG8_LAS __attribute__((address_space(3)))
typedef unsigned short bf16_t;
typedef short bf16x8 __attribute__((ext_vector_type(8)));
typedef float f32x4 __attribute__((ext_vector_type(4)));
typedef unsigned u32x4 __attribute__((ext_vector_type(4)));
constexpr int BM = 256, BK = 64, HALF = 128, HTB = HALF * BK * 2  , STAGE_BYTES = 8 * HTB, NXCD = 8, WGM = 8;

__host__ __device__ __forceinline__ int lds_byte(int r, int c) { const int st = (r >> 4) * 2 + (c >> 5), rr = r & 15, cc = c & 31, ob = rr * 64 + cc * 2; return st * 1024 + (ob ^ (((ob >> 9) & 1) << 5)); }
__host__ __device__ __forceinline__ void stage_rc(int b, int& R, int& C) { const int st = b / 1024, sb = b % 1024, swz = sb ^ (((sb >> 9) & 1) << 5); R = (st >> 1) * 16 + swz / 64; C = (st & 1) * 32 + (swz % 64) / 2; }
__host__ __device__ __forceinline__ int perm32(int rho) { const int n = rho >> 4, i = rho & 15; return 8 * (i >> 2) + 4 * n + (i & 3); }

struct Unit { int pm, pn; };
struct Gemm { const bf16_t* A; const bf16_t* Bt; int M, N, K; };

struct StaticOrder {
    int nM, nN, nwg, G, c;
    __host__ __device__ void init(int M, int N, int G_, int c_) { nM = M / BM; nN = N / BM; nwg = nM * nN; G = G_; c = c_; }
    __host__ __device__ bool next(int i, Unit& u) const {
        const long L = (long)i * G + c; if (L >= nwg) return false;
        int wgid = (int)L; { const int q = nwg / NXCD, r = nwg % NXCD, xcd = wgid % NXCD, off = wgid / NXCD; wgid = (xcd < r ? xcd * (q + 1) : r * (q + 1) + (xcd - r) * q) + off; }
        const int nig = WGM * nN, gid = wgid / nig, fm = gid * WGM, gsz = (nM - fm) < WGM ? (nM - fm) : WGM;
        u.pm = fm + ((wgid % nig) % gsz); u.pn = (wgid % nig) / gsz; return true;
    }
    __device__ __forceinline__ void a_ready(const Unit&) const {}
    __device__ __forceinline__ void done(const Unit&) const {}
};


typedef float cvf32x2_t __attribute__((ext_vector_type(2))); typedef __bf16 cvbf16x2_t __attribute__((ext_vector_type(2)));
__device__ __forceinline__ unsigned cvt_pk_bf16(float lo, float hi) { const cvf32x2_t v = {lo, hi}; const cvbf16x2_t b = __builtin_convertvector(v, cvbf16x2_t); return __builtin_bit_cast(unsigned, b); }
__device__ __forceinline__ float bf_lo(unsigned w) { return __builtin_bit_cast(float, w << 16); }
__device__ __forceinline__ float bf_hi(unsigned w) { return __builtin_bit_cast(float, w & 0xffff0000u); }
__device__ __forceinline__ float sigmoidf_(float v) { return __builtin_amdgcn_rcpf(1.0f + __builtin_amdgcn_exp2f(-v * 1.4426950408889634f)); }

struct EpiIn {
    static constexpr bool PERM = true, AFTER_DRAIN = false;
    bf16_t *QDA, *KDA, *VDA, *QNA, *KNA, *VNA, *SGDA, *SGNA;
    const float *gq_da, *gk_da, *gq_na, *gk_na;
    __device__ __forceinline__ void operator()(const f32x4 (&acc)[2][2][4][2], const Unit& u, int wr, int wc, int fr, int fq) const {
        const int pn = u.pn; const int row0 = u.pm * BM + wr * 64 + fr;
        int kind, ct; bf16_t* base; const float* gain = nullptr; float osc = 1.f;
        if (pn < 4)       { kind = 1; base = QDA; ct = pn;      gain = gq_da; osc = QSCALE; }
        else if (pn < 8)  { kind = 1; base = KDA; ct = pn - 4;  gain = gk_da; }
        else if (pn < 12) { kind = 0; base = VDA; ct = pn - 8; }
        else if (pn < 16) { kind = 1; base = QNA; ct = pn - 12; gain = gq_na; osc = QSCALE; }
        else if (pn < 20) { kind = 1; base = KNA; ct = pn - 16; gain = gk_na; }
        else if (pn < 24) { kind = 0; base = VNA; ct = pn - 20; }
        else if (pn < 32) { kind = 2; base = SGDA; ct = pn - 24; }
        else              { kind = 2; base = SGNA; ct = pn - 32; }
        if (kind == 1) {
            f32x4 gv[2][2];
#pragma unroll
            for (int bj = 0; bj < 2; ++bj)
#pragma unroll
                for (int n = 0; n < 2; ++n) gv[bj][n] = *(const f32x4*)(gain + 32 * bj + 8 * fq + 4 * n);
#pragma unroll
            for (int ai = 0; ai < 2; ++ai)
#pragma unroll
                for (int m = 0; m < 4; ++m) {
                    float ss = 0.f;
#pragma unroll
                    for (int bj = 0; bj < 2; ++bj)
#pragma unroll
                        for (int n = 0; n < 2; ++n) { const f32x4 x = acc[ai][bj][m][n]; ss += (x[0] * x[0] + x[1] * x[1]) + (x[2] * x[2] + x[3] * x[3]); }
                    ss += __shfl_xor(ss, 16); ss += __shfl_xor(ss, 32);
                    const float rs = __builtin_amdgcn_rsqf(ss * (1.0f / 64.0f) + EPS) * osc;
                    bf16_t* rowp = base + (size_t)(row0 + ai * HALF + m * 16) * 1024 + ct * 256 + 64 * wc + 8 * fq;
#pragma unroll
                    for (int bj = 0; bj < 2; ++bj) { const f32x4 v0 = acc[ai][bj][m][0] * rs * gv[bj][0], v1 = acc[ai][bj][m][1] * rs * gv[bj][1];
                        u32x4 w; w.x = cvt_pk_bf16(v0[0], v0[1]); w.y = cvt_pk_bf16(v0[2], v0[3]); w.z = cvt_pk_bf16(v1[0], v1[1]); w.w = cvt_pk_bf16(v1[2], v1[3]);
                        *(u32x4*)(rowp + 32 * bj) = w; }
                }
        } else {
            const int ldc = (kind == 2) ? 2048 : 1024;
#pragma unroll
            for (int ai = 0; ai < 2; ++ai)
#pragma unroll
                for (int m = 0; m < 4; ++m) {
                    bf16_t* rowp = base + (size_t)(row0 + ai * HALF + m * 16) * ldc + ct * 256 + 32 * wc + 8 * fq;
#pragma unroll
                    for (int bj = 0; bj < 2; ++bj) { f32x4 v0 = acc[ai][bj][m][0], v1 = acc[ai][bj][m][1];
                        if (kind == 2) {
#pragma unroll
                            for (int j = 0; j < 4; ++j) { v0[j] = sigmoidf_(v0[j]); v1[j] = sigmoidf_(v1[j]); } }
                        u32x4 w; w.x = cvt_pk_bf16(v0[0], v0[1]); w.y = cvt_pk_bf16(v0[2], v0[3]); w.z = cvt_pk_bf16(v1[0], v1[1]); w.w = cvt_pk_bf16(v1[2], v1[3]);
                        *(u32x4*)(rowp + bj * HALF) = w; }
                }
        }
    }
};

template <int MODE> struct EpiGate {
    static constexpr bool PERM = true, AFTER_DRAIN = false;
    const bf16_t* G; const bf16_t* P; bf16_t* Y;
    __device__ __forceinline__ void operator()(const f32x4 (&acc)[2][2][4][2], const Unit& u, int wr, int wc, int fr, int fq) const {
        const int row0 = u.pm * BM + wr * 64 + fr, col0 = u.pn * BM + wc * 32 + 8 * fq;
#pragma unroll
        for (int ai = 0; ai < 2; ++ai)
#pragma unroll
            for (int m = 0; m < 4; ++m) { const size_t off = (size_t)(row0 + ai * HALF + m * 16) * 2048 + col0;
#pragma unroll
                for (int bj = 0; bj < 2; ++bj) { const u32x4 g = *(const u32x4*)(G + off + bj * HALF); const f32x4 a0 = acc[ai][bj][m][0], a1 = acc[ai][bj][m][1];
                    float r[8] = { bf_lo(g.x) * a0[0], bf_hi(g.x) * a0[1], bf_lo(g.y) * a0[2], bf_hi(g.y) * a0[3], bf_lo(g.z) * a1[0], bf_hi(g.z) * a1[1], bf_lo(g.w) * a1[2], bf_hi(g.w) * a1[3] };
                    if (MODE == 1) { const u32x4 p = *(const u32x4*)(P + off + bj * HALF);
                        r[0] += bf_lo(p.x); r[1] += bf_hi(p.x); r[2] += bf_lo(p.y); r[3] += bf_hi(p.y); r[4] += bf_lo(p.z); r[5] += bf_hi(p.z); r[6] += bf_lo(p.w); r[7] += bf_hi(p.w); }
                    u32x4 w; w.x = cvt_pk_bf16(r[0], r[1]); w.y = cvt_pk_bf16(r[2], r[3]); w.z = cvt_pk_bf16(r[4], r[5]); w.w = cvt_pk_bf16(r[6], r[7]);
                    *(u32x4*)(Y + off + bj * HALF) = w; } }
    }
};

struct EpiOut {
    static constexpr bool PERM = false, AFTER_DRAIN = false;
    const float* X; float* OUT; bf16_t* H2G; const float* g2; float* SSP;
    __device__ __forceinline__ void operator()(const f32x4 (&acc)[2][2][4][2], const Unit& u, int wr, int wc, int fr, int fq) const {
        const int row0 = u.pm * BM + wr * 64 + fr, col0 = u.pn * BM + wc * 32 + 4 * fq;
        f32x4 gv[2][2];
#pragma unroll
        for (int bj = 0; bj < 2; ++bj)
#pragma unroll
            for (int n = 0; n < 2; ++n) gv[bj][n] = *(const f32x4*)(g2 + col0 + bj * HALF + n * 16);
#pragma unroll
        for (int ai = 0; ai < 2; ++ai)
#pragma unroll
            for (int m = 0; m < 4; ++m) { const int row = row0 + ai * HALF + m * 16; const size_t off = (size_t)row * 2048 + col0; float ss = 0.f;
#pragma unroll
                for (int bj = 0; bj < 2; ++bj)
#pragma unroll
                    for (int n = 0; n < 2; ++n) { const f32x4 h = *(const f32x4*)(X + off + bj * HALF + n * 16) + acc[ai][bj][m][n];
                        ss += (h[0] * h[0] + h[1] * h[1]) + (h[2] * h[2] + h[3] * h[3]);
                        const f32x4 hg = h * gv[bj][n]; unsigned long long w = (unsigned long long)cvt_pk_bf16(hg[0], hg[1]) | ((unsigned long long)cvt_pk_bf16(hg[2], hg[3]) << 32);
                        *(unsigned long long*)(H2G + off + bj * HALF + n * 16) = w; }
                ss += __shfl_xor(ss, 16); ss += __shfl_xor(ss, 32);
                if (fq == 0) SSP[(size_t)row * 32 + u.pn * 4 + wc] = ss; }
    }
};

__device__ __forceinline__ float row_rstd(const float* SSP, int row) {
    const f32x4* p = (const f32x4*)(SSP + (size_t)row * 32); float s = 0.f;
#pragma unroll
    for (int i = 0; i < 8; ++i) { const f32x4 v = p[i]; s += (v[0] + v[1]) + (v[2] + v[3]); }
    return __builtin_amdgcn_rsqf(s * (1.0f / 2048.0f) + EPS);
}
struct EpiPQ {
    static constexpr bool PERM = true, AFTER_DRAIN = false;
    bf16_t* PQ; const float* SSP;
    __device__ __forceinline__ void operator()(const f32x4 (&acc)[2][2][4][2], const Unit& u, int wr, int wc, int fr, int fq) const {
        const int row0 = u.pm * BM + wr * 64 + fr, col0 = u.pn * BM + wc * 32 + 8 * fq;
#pragma unroll
        for (int ai = 0; ai < 2; ++ai)
#pragma unroll
            for (int m = 0; m < 4; ++m) { const int row = row0 + ai * HALF + m * 16; const float rs = row_rstd(SSP, row);
                bf16_t* rowp = PQ + (size_t)row * 2048 + col0;
#pragma unroll
                for (int bj = 0; bj < 2; ++bj) { const f32x4 v0 = acc[ai][bj][m][0] * rs, v1 = acc[ai][bj][m][1] * rs;
                    u32x4 w; w.x = cvt_pk_bf16(v0[0], v0[1]); w.y = cvt_pk_bf16(v0[2], v0[3]); w.z = cvt_pk_bf16(v1[0], v1[1]); w.w = cvt_pk_bf16(v1[2], v1[3]);
                    *(u32x4*)(rowp + bj * HALF) = w; } }
    }
};

template <class Epi, class Sched, bool ALIGN_EPI = false, bool SP2 = false>
__device__ __forceinline__ void gemm_phase(PG8_LAS unsigned char* lds, const Gemm g, const Sched& S, const Epi& E) {
    const int tid = threadIdx.x, wid = __builtin_amdgcn_readfirstlane(tid >> 6), lane = tid & 63, wr = wid >> 2, wc = wid & 3, fr = lane & 15, fq = lane >> 4;
    const int K = g.K, nt = K / BK;
    unsigned voffA[2], voffB[2];
#pragma unroll
    for (int i = 0; i < 2; ++i) { int R, C; stage_rc(tid * 16 + i * 8192, R, C); const int Rb = Epi::PERM ? ((R & ~31) + perm32(R & 31)) : R;
        voffA[i] = (unsigned)(R * K + C) * 2u; voffB[i] = (unsigned)(Rb * K + C) * 2u; }
    const size_t kstep = (size_t)(BK * 2);
    const size_t hstep = (size_t)HALF * K * 2;
    const size_t tstep = 2 * hstep;
    const unsigned ldsw = (unsigned)wid * 1024u;
    const int aoff = lds_byte(wr * 64 + fr, fq * 8), boff = lds_byte(wc * 32 + fr, fq * 8);
#define PG8_SA(b, h) (((b) * 2 + (h)) * HTB)
#define PG8_SB(b, h) ((4 + (b) * 2 + (h)) * HTB)
#define PG8_STAGE(bufoff, gbase, voff) do { _Pragma("unroll") for (int _i = 0; _i < 2; ++_i) \
        __builtin_amdgcn_global_load_lds((const unsigned*)((const char*)(gbase) + (voff)[_i]), (PG8_LAS unsigned*)(lds + (bufoff) + ldsw + _i * 8192), 16, 0, 0); } while (0)
#define PG8_LDA(dst, b, h) do { _Pragma("unroll") for (int m = 0; m < 4; ++m) _Pragma("unroll") for (int k = 0; k < 2; ++k) dst[m][k] = *(const PG8_LAS bf16x8*)(lds + PG8_SA(b, h) + aoff + m * 2048 + k * 1024); } while (0)
#define PG8_LDB(dst, b, h) do { _Pragma("unroll") for (int n = 0; n < 2; ++n) _Pragma("unroll") for (int k = 0; k < 2; ++k) dst[n][k] = *(const PG8_LAS bf16x8*)(lds + PG8_SB(b, h) + boff + n * 2048 + k * 1024); } while (0)
#define PG8_MMA(ai, bj, At, Bt) do { __builtin_amdgcn_s_setprio(1); _Pragma("unroll") for (int m = 0; m < 4; ++m) _Pragma("unroll") for (int n = 0; n < 2; ++n) _Pragma("unroll") for (int k = 0; k < 2; ++k) \
        acc[ai][bj][m][n] = __builtin_amdgcn_mfma_f32_16x16x32_bf16(Bt[n][k], At[m][k], acc[ai][bj][m][n], 0, 0, 0); __builtin_amdgcn_s_setprio(0); } while (0)
#define PG8_WAIT_V(n) asm volatile("s_waitcnt vmcnt(" #n ")" ::: "memory")
#define PG8_WAIT_L(n) asm volatile("s_waitcnt lgkmcnt(" #n ")" ::: "memory")
#define PG8_BAR __builtin_amdgcn_s_barrier()
#define PG8_SCHED __builtin_amdgcn_sched_barrier(0)
    Unit cur, nxt; int ui = 0;
    if (!S.next(0, cur)) return;
    f32x4 acc[2][2][4][2];
#pragma unroll
    for (int a = 0; a < 2; ++a)
#pragma unroll
        for (int b = 0; b < 2; ++b)
#pragma unroll
            for (int m = 0; m < 4; ++m)
#pragma unroll
                for (int n = 0; n < 2; ++n) acc[a][b][m][n] = (f32x4){0.f, 0.f, 0.f, 0.f};
    bf16x8 At[4][2], B0[2][2], B1[2][2];
    const char* cA = (const char*)g.A + (size_t)cur.pm * tstep; const char* cB = (const char*)g.Bt + (size_t)cur.pn * tstep;
    S.a_ready(cur);
    if constexpr (SP2) {
        PG8_STAGE(PG8_SB(0, 0), cB, voffB); PG8_STAGE(PG8_SB(0, 1), cB + hstep, voffB); PG8_STAGE(PG8_SA(0, 0), cA, voffA); PG8_STAGE(PG8_SA(0, 1), cA + hstep, voffA);
        if (wr == 1) PG8_BAR;
        PG8_WAIT_V(2); PG8_BAR;
        PG8_STAGE(PG8_SB(1, 0), cB + kstep, voffB); PG8_STAGE(PG8_SA(1, 0), cA + kstep, voffA); PG8_STAGE(PG8_SB(1, 1), cB + hstep + kstep, voffB);
        PG8_WAIT_V(6); PG8_BAR;
    } else {
        PG8_STAGE(PG8_SB(0, 0), cB, voffB); PG8_STAGE(PG8_SA(0, 0), cA, voffA); PG8_STAGE(PG8_SB(0, 1), cB + hstep, voffB); PG8_STAGE(PG8_SA(0, 1), cA + hstep, voffA);
        if (wr == 1) PG8_BAR;
        PG8_WAIT_V(4); PG8_BAR;
        PG8_STAGE(PG8_SB(1, 0), cB + kstep, voffB); PG8_STAGE(PG8_SA(1, 0), cA + kstep, voffA); PG8_STAGE(PG8_SB(1, 1), cB + hstep + kstep, voffB);
        PG8_WAIT_V(6); PG8_BAR;
    }
    for (;;) {
        const bool has_next = S.next(ui + 1, nxt);
        const char* nA = has_next ? (const char*)g.A + (size_t)nxt.pm * tstep : cA; const char* nB = has_next ? (const char*)g.Bt + (size_t)nxt.pn * tstep : cB;
        for (int t = 0; t < nt; t += 2) {
            const bool last = (t == nt - 2);
            const char* a1 = cA + (size_t)(t + 1) * kstep;
            const char* a2 = last ? nA : cA + (size_t)(t + 2) * kstep; const char* b2 = last ? nB : cB + (size_t)(t + 2) * kstep;
            const char* a3 = a2 + kstep; const char* b3 = b2 + kstep;
            if (last && has_next) S.a_ready(nxt);
            if constexpr (SP2) {
            PG8_LDB(B0, 0, 0); PG8_LDB(B1, 0, 1); PG8_SCHED; PG8_LDA(At, 0, 0); PG8_STAGE(PG8_SA(1, 1), a1 + hstep, voffA);
            PG8_WAIT_V(8); PG8_WAIT_L(0); PG8_BAR; PG8_MMA(0, 0, At, B0); PG8_MMA(0, 1, At, B1); PG8_BAR; PG8_SCHED;
            PG8_LDA(At, 0, 1); PG8_STAGE(PG8_SB(0, 0), b2, voffB); PG8_STAGE(PG8_SB(0, 1), b2 + hstep, voffB); PG8_STAGE(PG8_SA(0, 0), a2, voffA);
            PG8_WAIT_V(8); PG8_WAIT_L(0); PG8_BAR; PG8_MMA(1, 0, At, B0); PG8_MMA(1, 1, At, B1); PG8_BAR; PG8_SCHED;
            PG8_LDB(B0, 1, 0); PG8_LDB(B1, 1, 1); PG8_SCHED; PG8_LDA(At, 1, 0); PG8_STAGE(PG8_SA(0, 1), a2 + hstep, voffA);
            PG8_WAIT_V(8); PG8_WAIT_L(0); PG8_BAR; PG8_MMA(0, 0, At, B0); PG8_MMA(0, 1, At, B1); PG8_BAR; PG8_SCHED;
            PG8_LDA(At, 1, 1); PG8_STAGE(PG8_SB(1, 0), b3, voffB); PG8_STAGE(PG8_SB(1, 1), b3 + hstep, voffB); PG8_STAGE(PG8_SA(1, 0), a3, voffA);
            PG8_WAIT_V(8); PG8_WAIT_L(0); PG8_BAR; PG8_MMA(1, 0, At, B0); PG8_MMA(1, 1, At, B1); PG8_BAR; PG8_SCHED;
            } else {
            PG8_LDB(B0, 0, 0); PG8_SCHED; PG8_LDA(At, 0, 0); PG8_STAGE(PG8_SA(1, 1), a1 + hstep, voffA);
            PG8_WAIT_L(8); PG8_BAR; PG8_WAIT_L(0); PG8_MMA(0, 0, At, B0); PG8_BAR; PG8_SCHED;
            PG8_LDB(B1, 0, 1); PG8_STAGE(PG8_SB(0, 0), b2, voffB);
            PG8_BAR; PG8_WAIT_L(0); PG8_MMA(0, 1, At, B1); PG8_BAR;
            PG8_LDA(At, 0, 1); PG8_STAGE(PG8_SA(0, 0), a2, voffA);
            PG8_BAR; PG8_WAIT_L(0); PG8_MMA(1, 0, At, B0); PG8_BAR; PG8_SCHED;
            PG8_STAGE(PG8_SB(0, 1), b2 + hstep, voffB);
            PG8_WAIT_V(6); PG8_BAR; PG8_MMA(1, 1, At, B1); PG8_BAR;
            PG8_LDB(B0, 1, 0); PG8_SCHED; PG8_LDA(At, 1, 0); PG8_STAGE(PG8_SA(0, 1), a2 + hstep, voffA);
            PG8_WAIT_L(8); PG8_BAR; PG8_WAIT_L(0); PG8_MMA(0, 0, At, B0); PG8_BAR; PG8_SCHED;
            PG8_LDB(B1, 1, 1); PG8_STAGE(PG8_SB(1, 0), b3, voffB);
            PG8_BAR; PG8_WAIT_L(0); PG8_MMA(0, 1, At, B1); PG8_BAR;
            PG8_LDA(At, 1, 1); PG8_STAGE(PG8_SA(1, 0), a3, voffA);
            PG8_BAR; PG8_WAIT_L(0); PG8_MMA(1, 0, At, B0); PG8_BAR; PG8_SCHED;
            PG8_STAGE(PG8_SB(1, 1), b3 + hstep, voffB);
            PG8_WAIT_V(6); PG8_BAR; PG8_MMA(1, 1, At, B1); PG8_BAR;
            }
        }
        if constexpr (ALIGN_EPI) { if (wr == 0) PG8_BAR; }
        if constexpr (!Epi::AFTER_DRAIN) { E(acc, cur, wr, wc, fr, fq); S.done(cur); }
        if (!has_next) break;
#pragma unroll
        for (int a = 0; a < 2; ++a)
#pragma unroll
            for (int b = 0; b < 2; ++b)
#pragma unroll
                for (int m = 0; m < 4; ++m)
#pragma unroll
                    for (int n = 0; n < 2; ++n) acc[a][b][m][n] = (f32x4){0.f, 0.f, 0.f, 0.f};
        cur = nxt; cA = nA; cB = nB; ++ui;
        if constexpr (ALIGN_EPI) { if (wr == 1) PG8_BAR; }
    }
    PG8_WAIT_V(0);
    if constexpr (!ALIGN_EPI) { if (wr == 0) PG8_BAR; }
    PG8_BAR;
    if constexpr (Epi::AFTER_DRAIN) { E.fused(acc, cur, wr, wc, fr, fq, lds, wid, lane); S.done(cur); }
#undef PG8_SA
#undef PG8_SB
#undef PG8_STAGE
#undef PG8_LDA
#undef PG8_LDB
#undef PG8_MMA
#undef PG8_WAIT_V
#undef PG8_WAIT_L
#undef PG8_BAR
#undef PG8_SCHED
}
}

namespace att {
#define ATT_LAS __attribute__((address_space(3)))
typedef unsigned short bf16_t;
typedef short bf16x8 __attribute__((ext_vector_type(8)));
typedef short s16x4 __attribute__((ext_vector_type(4)));
typedef float f32x16 __attribute__((ext_vector_type(16)));
typedef float f32x4 __attribute__((ext_vector_type(4)));
typedef unsigned u32x4 __attribute__((ext_vector_type(4)));
typedef unsigned u32x2 __attribute__((ext_vector_type(2)));
typedef ATT_LAS const char* lds_cptr;
constexpr int NSLOT = 4, KSLOT = 8192, VSLOT = 16384;
constexpr int LDS_K = 0, LDS_V = NSLOT * KSLOT, LDS_TBL = LDS_V + NSLOT * VSLOT, TBL_FLOATS = 640, LDS_BYTES = LDS_TBL + TBL_FLOATS * 4;

__device__ __forceinline__ void glds16(const void* gsrc, unsigned lds_dst) { unsigned keep;
    asm volatile("s_mov_b32 %0, m0\n\ts_mov_b32 m0, %2\n\ts_nop 0\n\tglobal_load_lds_dwordx4 %1, off\n\ts_mov_b32 m0, %0" : "=&s"(keep) : "v"(gsrc), "s"(lds_dst) : "memory"); }
#define ATT_WAIT_BAR(N) asm volatile("s_waitcnt vmcnt(" #N ") lgkmcnt(0)\n\ts_barrier" ::: "memory")
__device__ __forceinline__ unsigned cvtpk(float lo, float hi) { return pg8::cvt_pk_bf16(lo, hi); }
typedef short v4i16_t __attribute__((ext_vector_type(4)));
__device__ __forceinline__ s16x4 vtr(lds_cptr p) { return __builtin_bit_cast(s16x4, __builtin_amdgcn_ds_read_tr16_b64_v4i16((ATT_LAS v4i16_t*)p)); }
__device__ __forceinline__ int crow(int r, int hi) { return (r & 3) + 8 * (r >> 2) + 4 * hi; }

template <int KIND>
__device__ __forceinline__ void na_tile(lds_cptr Ks, lds_cptr Vl, const bf16x8 (&qr)[4], f32x16 (&oT)[2], float& mref, float& lsum, const f32x16& ma0, const f32x16& ma1, const ATT_LAS float* tb, int r32, int hi) {
#define NA_V0(r) (KIND == 0 || (KIND == 1 && (r) >= 12))
#define NA_V1(r) ((KIND == 0 && (r) < 4) || KIND == 1 || (KIND == 2 && (r) >= 8))
    f32x16 p0, p1;
#pragma unroll
    for (int r = 0; r < 16; ++r) { p0[r] = (KIND == 2) ? 0.f : ma0[r] - mref; p1[r] = (KIND == 2) ? -mref : ma1[r] - mref; }
    const lds_cptr kb = Ks + hi * 1024 + r32 * 16;
#pragma unroll
    for (int d0 = 0; d0 < 4; ++d0) {
        if (KIND != 2) { const bf16x8 b0 = *(const ATT_LAS bf16x8*)(kb + d0 * 2048); p0 = __builtin_amdgcn_mfma_f32_32x32x16_bf16(b0, qr[d0], p0, 0, 0, 0); }
        { const bf16x8 b1 = *(const ATT_LAS bf16x8*)(kb + d0 * 2048 + 512); p1 = __builtin_amdgcn_mfma_f32_32x32x16_bf16(b1, qr[d0], p1, 0, 0, 0); }
    }
    if (KIND != 2) {
#pragma unroll
        for (int r = 0; r < 16; ++r) { const int cr = (r & 3) + 8 * (r >> 2); if (NA_V0(r)) p0[r] += tb[cr]; if (NA_V1(r)) p1[r] += tb[cr + 32]; }
    }
    float tm = -3.0e38f;
#pragma unroll
    for (int r = 0; r < 16; ++r) { if (NA_V0(r)) tm = __builtin_fmaxf(tm, p0[r]); if (NA_V1(r)) tm = __builtin_fmaxf(tm, p1[r]); }
    { const auto rr = __builtin_amdgcn_permlane32_swap(__builtin_bit_cast(unsigned, tm), __builtin_bit_cast(unsigned, tm), false, false);
      tm = __builtin_fmaxf(__builtin_bit_cast(float, rr[0]), __builtin_bit_cast(float, rr[1])); }
    if (__any(tm > 8.0f)) {
        const float d = __builtin_fmaxf(tm, 0.f), alpha = __builtin_amdgcn_exp2f(-d);
        mref += d; lsum *= alpha;
#pragma unroll
        for (int r = 0; r < 16; ++r) { p0[r] -= d; p1[r] -= d; }
#pragma unroll
        for (int db = 0; db < 2; ++db)
#pragma unroll
            for (int r = 0; r < 16; ++r) oT[db][r] *= alpha;
    }
    float s0 = 0.f, s1 = 0.f;
#pragma unroll
    for (int r = 0; r < 16; ++r) {
        if (NA_V0(r)) { p0[r] = __builtin_amdgcn_exp2f(p0[r]); s0 += p0[r]; } else p0[r] = 0.f;
        if (NA_V1(r)) { p1[r] = __builtin_amdgcn_exp2f(p1[r]); s1 += p1[r]; } else p1[r] = 0.f; }
    lsum += s0 + s1;
    bf16x8 pw[4];
    { u32x4 w;
      w.x = cvtpk(p0[0], p0[1]); w.y = cvtpk(p0[2], p0[3]); w.z = cvtpk(p0[4], p0[5]); w.w = cvtpk(p0[6], p0[7]); pw[0] = __builtin_bit_cast(bf16x8, w);
      w.x = cvtpk(p0[8], p0[9]); w.y = cvtpk(p0[10], p0[11]); w.z = cvtpk(p0[12], p0[13]); w.w = cvtpk(p0[14], p0[15]); pw[1] = __builtin_bit_cast(bf16x8, w);
      w.x = cvtpk(p1[0], p1[1]); w.y = cvtpk(p1[2], p1[3]); w.z = cvtpk(p1[4], p1[5]); w.w = cvtpk(p1[6], p1[7]); pw[2] = __builtin_bit_cast(bf16x8, w);
      w.x = cvtpk(p1[8], p1[9]); w.y = cvtpk(p1[10], p1[11]); w.z = cvtpk(p1[12], p1[13]); w.w = cvtpk(p1[14], p1[15]); pw[3] = __builtin_bit_cast(bf16x8, w); }
#pragma unroll
    for (int db = 0; db < 2; ++db)
#pragma unroll
        for (int ks = 0; ks < 4; ++ks) {
            const bool live = (ks == 0) ? NA_V0(0) : (ks == 1) ? NA_V0(15) : (ks == 2) ? NA_V1(0) : NA_V1(15);
            if (live) {
                const lds_cptr vp = Vl + db * 4096 + ks * 1024;
                const s16x4 lo = vtr(vp), h4 = vtr(vp + 512);
                const bf16x8 vf = (bf16x8){lo[0], lo[1], lo[2], lo[3], h4[0], h4[1], h4[2], h4[3]};
                oT[db] = __builtin_amdgcn_mfma_f32_32x32x16_bf16(vf, pw[ks], oT[db], 0, 0, 0);
            }
        }
#undef NA_V0
#undef NA_V1
}

__device__ __forceinline__ void store_block_w16(bf16_t* rowp, const f32x16& o, float sc, int hi) {
#pragma unroll
    for (int g = 0; g < 4; g += 2) {
        unsigned ax = cvtpk(o[4 * g] * sc, o[4 * g + 1] * sc), ay = cvtpk(o[4 * g + 2] * sc, o[4 * g + 3] * sc);
        unsigned bx = cvtpk(o[4 * g + 4] * sc, o[4 * g + 5] * sc), by = cvtpk(o[4 * g + 6] * sc, o[4 * g + 7] * sc);
        { const auto r = __builtin_amdgcn_permlane32_swap(ax, bx, false, false); ax = r[0]; bx = r[1]; }
        { const auto r = __builtin_amdgcn_permlane32_swap(ay, by, false, false); ay = r[0]; by = r[1]; }
        *(u32x4*)(rowp + 8 * (g + hi)) = (u32x4){ax, ay, bx, by};
    }
}

struct DAParams { const bf16_t *Q, *K, *V, *Kmeta, *Vmeta; bf16_t* OC; float mref; };

template <bool GEN, bool META, bool DO_PV>
__device__ __forceinline__ void da_step(lds_cptr Ks, lds_cptr Vp, const bf16x8 (&qr)[4], bf16x8 qx, bf16x8 kx0, bf16x8 kx1, f32x16 (&oT)[4], float& lsum, bf16x8 (&pw)[4],
                                        float qrel4, float sl2, float mref, int r32, int hi) {
#define SBAR() __builtin_amdgcn_sched_barrier(0)
#define DA_VFRAG(dst, i) do { const lds_cptr vp_ = Vp + ((i) >> 2) * 4096 + ((i) & 3) * 1024; const s16x4 lo_ = vtr(vp_), h4_ = vtr(vp_ + 512); \
        dst = (bf16x8){lo_[0], lo_[1], lo_[2], lo_[3], h4_[0], h4_[1], h4_[2], h4_[3]}; } while (0)
    constexpr int PF = 5, NR = 6;
    bf16x8 vf[NR];
    if (DO_PV) {
#pragma unroll
        for (int i = 0; i < PF; ++i) DA_VFRAG(vf[i], i);
    }
    f32x16 p0, p1;
    if (GEN) {
#pragma unroll
        for (int r = 0; r < 16; ++r) { p0[r] = -mref; p1[r] = -mref; }
    } else {
        f32x16 z;
#pragma unroll
        for (int r = 0; r < 16; ++r) z[r] = 0.f;
        p0 = __builtin_amdgcn_mfma_f32_32x32x16_bf16(kx0, qx, z, 0, 0, 0);
        p1 = __builtin_amdgcn_mfma_f32_32x32x16_bf16(kx1, qx, z, 0, 0, 0);
    }
    const lds_cptr kb = Ks + hi * 1024 + r32 * 16;
#pragma unroll
    for (int d0 = 0; d0 < 4; ++d0) {
        const bf16x8 b0 = *(const ATT_LAS bf16x8*)(kb + d0 * 2048), b1 = *(const ATT_LAS bf16x8*)(kb + d0 * 2048 + 512);
        p0 = __builtin_amdgcn_mfma_f32_32x32x16_bf16(b0, qr[d0], p0, 0, 0, 0);
        p1 = __builtin_amdgcn_mfma_f32_32x32x16_bf16(b1, qr[d0], p1, 0, 0, 0);
    }
    if (GEN) {
#pragma unroll
        for (int r = 0; r < 16; ++r) { const float c = (float)((r & 3) + 8 * (r >> 2));
            p0[r] = __builtin_fmaf(-sl2, __builtin_fabsf(qrel4 - c), p0[r]);
            p1[r] = __builtin_fmaf(-sl2, __builtin_fabsf(qrel4 - (c + 32.0f)), p1[r]); }
    }
    if (META) {
#pragma unroll
        for (int r = 0; r < 16; ++r) p0[r] = NEGBIG;
#pragma unroll
        for (int r = 0; r < 8; ++r) p1[r] = NEGBIG;
    }
    if (DO_PV) {
        float s0 = 0.f, s1 = 0.f;
        SBAR();
#pragma unroll
        for (int i = 0; i < 16; ++i) {
            if (i + PF < 16) DA_VFRAG(vf[(i + PF) % NR], i + PF);
            SBAR();
            oT[i >> 2] = __builtin_amdgcn_mfma_f32_32x32x16_bf16(vf[i % NR], pw[i & 3], oT[i >> 2], 0, 0, 0);
            SBAR();
            if (i < 8) { p0[2 * i] = __builtin_amdgcn_exp2f(p0[2 * i]); p0[2 * i + 1] = __builtin_amdgcn_exp2f(p0[2 * i + 1]); s0 += p0[2 * i]; s1 += p0[2 * i + 1]; }
            else { p1[2 * i - 16] = __builtin_amdgcn_exp2f(p1[2 * i - 16]); p1[2 * i - 15] = __builtin_amdgcn_exp2f(p1[2 * i - 15]); s0 += p1[2 * i - 16]; s1 += p1[2 * i - 15]; }
            asm volatile("" : "+v"(s0), "+v"(s1));
            SBAR();
        }
        lsum += s0 + s1;
#pragma unroll
        for (int ks = 0; ks < 4; ++ks) {
            { u32x4 w;
              if (ks == 0) { w.x = cvtpk(p0[0], p0[1]); w.y = cvtpk(p0[2], p0[3]); w.z = cvtpk(p0[4], p0[5]); w.w = cvtpk(p0[6], p0[7]); }
              else if (ks == 1) { w.x = cvtpk(p0[8], p0[9]); w.y = cvtpk(p0[10], p0[11]); w.z = cvtpk(p0[12], p0[13]); w.w = cvtpk(p0[14], p0[15]); }
              else if (ks == 2) { w.x = cvtpk(p1[0], p1[1]); w.y = cvtpk(p1[2], p1[3]); w.z = cvtpk(p1[4], p1[5]); w.w = cvtpk(p1[6], p1[7]); }
              else { w.x = cvtpk(p1[8], p1[9]); w.y = cvtpk(p1[10], p1[11]); w.z = cvtpk(p1[12], p1[13]); w.w = cvtpk(p1[14], p1[15]); }
              pw[ks] = __builtin_bit_cast(bf16x8, w); }
        }
    } else {
        float s0 = 0.f, s1 = 0.f;
#pragma unroll
        for (int r = 0; r < 16; ++r) { p0[r] = __builtin_amdgcn_exp2f(p0[r]); p1[r] = __builtin_amdgcn_exp2f(p1[r]); s0 += p0[r]; s1 += p1[r]; }
        lsum += s0 + s1;
        u32x4 w;
        w.x = cvtpk(p0[0], p0[1]); w.y = cvtpk(p0[2], p0[3]); w.z = cvtpk(p0[4], p0[5]); w.w = cvtpk(p0[6], p0[7]); pw[0] = __builtin_bit_cast(bf16x8, w);
        w.x = cvtpk(p0[8], p0[9]); w.y = cvtpk(p0[10], p0[11]); w.z = cvtpk(p0[12], p0[13]); w.w = cvtpk(p0[14], p0[15]); pw[1] = __builtin_bit_cast(bf16x8, w);
        w.x = cvtpk(p1[0], p1[1]); w.y = cvtpk(p1[2], p1[3]); w.z = cvtpk(p1[4], p1[5]); w.w = cvtpk(p1[6], p1[7]); pw[2] = __builtin_bit_cast(bf16x8, w);
        w.x = cvtpk(p1[8], p1[9]); w.y = cvtpk(p1[10], p1[11]); w.z = cvtpk(p1[12], p1[13]); w.w = cvtpk(p1[14], p1[15]); pw[3] = __builtin_bit_cast(bf16x8, w);
    }
#undef DA_VFRAG
#undef SBAR
}

__device__ __forceinline__ void da_unit(ATT_LAS char* lds, unsigned lds0, const DAParams& P, int b, int h, int c, int qb, int Tlo, int Thi) {
    int tid = threadIdx.x; asm volatile("" : "+v"(tid));
    const int lane = tid & 63, r32 = lane & 31, hi = lane >> 5; const int wid = __builtin_amdgcn_readfirstlane(tid >> 6);
    const int qi0 = qb * 256 + wid * 32, qi = qi0 + r32;
    const size_t mrow = (size_t)b * SEQ + qi;
    const float slp2 = __builtin_amdgcn_exp2f(-(float)(h + 1)) * LOG2E, mref = P.mref;
    const lds_cptr ldsc = (lds_cptr)lds;
    const lds_cptr vl0 = ldsc + LDS_V + ((lane >> 4) & 1) * 32 + (lane & 3) * 8 + (4 * hi + ((lane & 15) >> 2)) * 64;
    const bf16_t* Qp = P.Q + mrow * 1024 + h * 128 + c * 64;
    bf16x8 qr[4];
#pragma unroll
    for (int d0 = 0; d0 < 4; ++d0) qr[d0] = *(const bf16x8*)(Qp + d0 * 16 + hi * 8);
    asm volatile("s_waitcnt vmcnt(0)" : "+v"(qr[0]), "+v"(qr[1]), "+v"(qr[2]), "+v"(qr[3]) :: "memory");
    const int kcol = h * 128 + c * 64, vcol = h * 128;
    const bf16_t* kreal = P.K + (size_t)b * SEQ * 1024 + kcol + (size_t)lane * 1024 + wid * 8;
    const bf16_t* kmeta = P.Kmeta + kcol + (size_t)lane * 1024 + wid * 8;
    const int vro = (16 * (wid & 3) + (lane >> 2)) * 1024 + (lane & 3) * 8;
    const bf16_t* vreal = P.V + (size_t)b * SEQ * 1024 + vcol + vro + 32 * (wid >> 2);
    const bf16_t* vmeta = P.Vmeta + vcol + vro + 32 * (wid >> 2);
#define DA_DMA(T, slot) do { const int T_ = (T); const unsigned so_ = (unsigned)(slot); \
    const bf16_t* ks_ = T_ == 0 ? kmeta : kreal + (size_t)(T_ - 1) * 65536; const bf16_t* vs_ = T_ == 0 ? vmeta : vreal + (size_t)(T_ - 1) * 65536; \
    glds16(ks_, (unsigned)__builtin_amdgcn_readfirstlane(lds0 + LDS_K + so_ * KSLOT + wid * 1024)); \
    glds16(vs_, (unsigned)__builtin_amdgcn_readfirstlane(lds0 + LDS_V + so_ * VSLOT + wid * 1024)); \
    glds16(vs_ + 64, (unsigned)__builtin_amdgcn_readfirstlane(lds0 + LDS_V + so_ * VSLOT + (wid + 8) * 1024)); } while (0)
#define DA_MODE(T) ((qi0 - 64 * ((T) - 1) - 4 >= 59) ? 0 : ((qi0 - 64 * ((T) - 1) + 31 <= 0) ? 1 : 2))
    bf16x8 kx0, kx1;
    { const unsigned m = hi ? 0u : 0xffffffffu;
      const u32x4 a0 = (u32x4){cvtpk((float)r32, (float)r32) & m, 0x3f803f80u & m, 0u, 0u}, a1 = (u32x4){cvtpk((float)(r32 + 32), (float)(r32 + 32)) & m, 0x3f803f80u & m, 0u, 0u};
      kx0 = __builtin_bit_cast(bf16x8, a0); kx1 = __builtin_bit_cast(bf16x8, a1); }
    const float sg_hi = __builtin_bit_cast(float, cvtpk(slp2, 0.f) << 16), sg_lo = slp2 - sg_hi;
#define DA_QX(dst, T, md) do { const float sg_ = ((md) == 0) ? 1.0f : -1.0f; const float lb_ = -sg_ * slp2 * (float)(qi - 64 * ((T) - 1)) - mref; \
        const float lbh_ = __builtin_bit_cast(float, cvtpk(lb_, 0.f) << 16); const unsigned m_ = hi ? 0u : 0xffffffffu; \
        const u32x4 q_ = (u32x4){cvtpk(sg_ * sg_hi, sg_ * sg_lo) & m_, cvtpk(lbh_, lb_ - lbh_) & m_, 0u, 0u}; dst = __builtin_bit_cast(bf16x8, q_); } while (0)
    f32x16 oT[4]; float lsum = 0.f;
#pragma unroll
    for (int r = 0; r < 16; ++r) { oT[0][r] = 0.f; oT[1][r] = 0.f; oT[2][r] = 0.f; oT[3][r] = 0.f; }
    bf16x8 pw[4];
    DA_DMA(Tlo, 0); DA_DMA(Tlo + 1, 1);
    ATT_WAIT_BAR(3);
    DA_DMA(Tlo + 2, 2);
    { const int md = DA_MODE(Tlo); bf16x8 qx; DA_QX(qx, Tlo, md); const float q4 = (float)(qi - 64 * (Tlo - 1) - 4 * hi);
      if (Tlo == 0) da_step<false, true, false>(ldsc + LDS_K, vl0, qr, qx, kx0, kx1, oT, lsum, pw, q4, slp2, mref, r32, hi);
      else if (md == 2) da_step<true, false, false>(ldsc + LDS_K, vl0, qr, qx, kx0, kx1, oT, lsum, pw, q4, slp2, mref, r32, hi);
      else da_step<false, false, false>(ldsc + LDS_K, vl0, qr, qx, kx0, kx1, oT, lsum, pw, q4, slp2, mref, r32, hi); }
    int sk = 1, sv = 0, sd = 3;
#pragma unroll 1
    for (int T = Tlo + 1; T <= Thi; ++T) {
        if (T + 1 <= Thi) ATT_WAIT_BAR(3); else ATT_WAIT_BAR(0);
        if (T + 2 <= Thi) DA_DMA(T + 2, sd);
        const int md = DA_MODE(T); bf16x8 qx; DA_QX(qx, T, md); const float q4 = (float)(qi - 64 * (T - 1) - 4 * hi);
        if (md == 2) da_step<true, false, true>(ldsc + LDS_K + sk * KSLOT, vl0 + sv * VSLOT, qr, qx, kx0, kx1, oT, lsum, pw, q4, slp2, mref, r32, hi);
        else da_step<false, false, true>(ldsc + LDS_K + sk * KSLOT, vl0 + sv * VSLOT, qr, qx, kx0, kx1, oT, lsum, pw, q4, slp2, mref, r32, hi);
        sk = (sk + 1) & 3; sv = (sv + 1) & 3; sd = (sd + 1) & 3;
    }
    {
        const lds_cptr Vp = vl0 + sv * VSLOT;
#pragma unroll
        for (int db = 0; db < 4; ++db)
#pragma unroll
            for (int ks = 0; ks < 4; ++ks) { const lds_cptr vp = Vp + db * 4096 + ks * 1024; const s16x4 lo = vtr(vp), h4 = vtr(vp + 512);
                const bf16x8 vf = (bf16x8){lo[0], lo[1], lo[2], lo[3], h4[0], h4[1], h4[2], h4[3]}; oT[db] = __builtin_amdgcn_mfma_f32_32x32x16_bf16(vf, pw[ks], oT[db], 0, 0, 0); }
    }
    ATT_WAIT_BAR(0);
#undef DA_DMA
#undef DA_QX
#undef DA_MODE
    const float inv = __builtin_amdgcn_rcpf(lsum + __shfl_xor(lsum, 32));
    bf16_t* Op = P.OC + (size_t)c * M * 1024 + mrow * 1024 + h * 128;
#pragma unroll
    for (int db = 0; db < 4; ++db) store_block_w16(Op + 32 * db, oT[db], inv, hi);
    asm volatile("s_waitcnt vmcnt(0)" ::: "memory");
}

struct NAParams { const bf16_t *Q, *K, *V, *Kmeta, *Vmeta; bf16_t* O; const float* rpb; };

__device__ __forceinline__ void na_unit(ATT_LAS char* lds, unsigned lds0, const NAParams& P, int b, int h, int rblk) {
    const int tid = threadIdx.x, lane = tid & 63, r32 = lane & 31, hi = lane >> 5; const int wid = __builtin_amdgcn_readfirstlane(tid >> 6);
    const lds_cptr ldsc = (lds_cptr)lds;
    ATT_LAS float* tbl = (ATT_LAS float*)(lds + LDS_TBL);
    { int tq = tid; asm volatile("" : "+v"(tq));
      if (tq < 465) tbl[64 + tq] = P.rpb[h * 465 + tq] * LOG2E; }
    const int rq = 4 * rblk + (wid >> 1), c = 32 * (wid & 1) + r32;
    int cs = c - 8; cs = cs < 0 ? 0 : (cs > 48 ? 48 : cs);
    int r0 = rq - 4; r0 = r0 < 0 ? 0 : (r0 > 120 ? 120 : r0);
    int jlo = 4 * rblk - 4; jlo = jlo < 0 ? 0 : (jlo > 120 ? 120 : jlo);
    int jhi = 4 * rblk - 1; jhi = (jhi < 0 ? 0 : (jhi > 120 ? 120 : jhi)) + 7;
    const int NT = jhi - jlo + 2;
    const size_t mrow = (size_t)b * SEQ + 64 * rq + c;
    const bf16_t* Qp = P.Q + mrow * 1024 + h * 64;
    bf16x8 qr[4];
#pragma unroll
    for (int d0 = 0; d0 < 4; ++d0) qr[d0] = *(const bf16x8*)(Qp + d0 * 16 + hi * 8);
    asm volatile("s_waitcnt vmcnt(0)" : "+v"(qr[0]), "+v"(qr[1]), "+v"(qr[2]), "+v"(qr[3]) :: "memory");
    const int kcol = h * 64;
    const bf16_t* kreal = P.K + ((size_t)b * SEQ + (size_t)jlo * 64) * 1024 + kcol + (size_t)lane * 1024 + wid * 8;
    const bf16_t* kmeta = P.Kmeta + kcol + (size_t)lane * 1024 + wid * 8;
    const int vro = (16 * (wid & 3) + (lane >> 2)) * 1024 + (lane & 3) * 8 + 32 * (wid >> 2);
    const bf16_t* vreal = P.V + ((size_t)b * SEQ + (size_t)jlo * 64) * 1024 + kcol + vro;
    const bf16_t* vmeta = P.Vmeta + kcol + vro;
    const lds_cptr vl0 = ldsc + LDS_V + ((lane >> 4) & 1) * 32 + (lane & 3) * 8 + (4 * hi + ((lane & 15) >> 2)) * 64;
#define NA_DMA(t, slot) do { const int t_ = (t); const unsigned so_ = (unsigned)(slot); \
    const bf16_t* ks_ = t_ == NT - 1 ? kmeta : kreal + (size_t)t_ * 65536; const bf16_t* vs_ = t_ == NT - 1 ? vmeta : vreal + (size_t)t_ * 65536; \
    glds16(ks_, (unsigned)__builtin_amdgcn_readfirstlane(lds0 + LDS_K + so_ * KSLOT + wid * 1024)); \
    glds16(vs_, (unsigned)__builtin_amdgcn_readfirstlane(lds0 + LDS_V + so_ * VSLOT + wid * 1024)); } while (0)
    f32x16 oT[2];
#pragma unroll
    for (int db = 0; db < 2; ++db)
#pragma unroll
        for (int r = 0; r < 16; ++r) oT[db][r] = 0.f;
    float mref = 0.f, lsum = 0.f;
    f32x16 ma0, ma1;
#pragma unroll
    for (int r = 0; r < 16; ++r) { const int cr = (r & 3) + 8 * (r >> 2) + 4 * hi - cs;
        ma0[r] = ((unsigned)cr < 16u) ? 0.f : NEGBIG; ma1[r] = ((unsigned)(cr + 32) < 16u) ? 0.f : NEGBIG; }
    NA_DMA(0, 0); NA_DMA(1, 1);
    int sl = 0, sl2 = 2;
#pragma unroll 1
    for (int t = 0; t < NT; ++t) {
        if (t + 1 < NT) ATT_WAIT_BAR(2); else ATT_WAIT_BAR(0);
        if (t + 2 < NT) NA_DMA(t + 2, sl2);
        const int jr = jlo + t; const bool meta = (t == NT - 1);
        if (meta || (jr >= r0 && jr < r0 + 8)) {
            const ATT_LAS float* tb = tbl + 64 + (jr - rq + 7) * 31 + 4 * hi - c + 15;
            if (meta) na_tile<2>(ldsc + LDS_K + sl * KSLOT, vl0 + sl * VSLOT, qr, oT, mref, lsum, ma0, ma1, tb, r32, hi);
            else if (wid & 1) na_tile<1>(ldsc + LDS_K + sl * KSLOT, vl0 + sl * VSLOT, qr, oT, mref, lsum, ma0, ma1, tb, r32, hi);
            else na_tile<0>(ldsc + LDS_K + sl * KSLOT, vl0 + sl * VSLOT, qr, oT, mref, lsum, ma0, ma1, tb, r32, hi);
        }
        sl = (sl == 2) ? 0 : sl + 1; sl2 = (sl2 == 2) ? 0 : sl2 + 1;
    }
    ATT_WAIT_BAR(0);
#undef NA_DMA
    const float l = lsum + __shfl_xor(lsum, 32), inv = __builtin_amdgcn_rcpf(l);
    bf16_t* Op = P.O + mrow * 1024 + h * 64;
#pragma unroll
    for (int db = 0; db < 2; ++db) store_block_w16(Op + 32 * db, oT[db], inv, hi);
    asm volatile("s_waitcnt vmcnt(0)" ::: "memory");
}
}


constexpr int NWAVES = 8;
#ifndef MK_N_LAUNCHES
#define MK_N_LAUNCHES 1
#endif
constexpr int N_LAUNCHES = MK_N_LAUNCHES, N_PHASES = 11;

constexpr size_t MiB = 1u << 20;
constexpr size_t WS_CTL = 0, CTL_ZERO_BYTES = 1 * MiB;
constexpr size_t WS_WIN_T = 2 * MiB;
constexpr size_t WS_WBDA_T = 42 * MiB, WS_WBNA_T = 46 * MiB;
constexpr size_t WS_WOUT_T = 50 * MiB, WS_WQ_T = 58 * MiB;
constexpr size_t WS_SK = 66 * MiB;
constexpr size_t WS_XNM = 66 * MiB + 64 * 1024;
constexpr size_t WS_METAKV = 66 * MiB + 128 * 1024;
constexpr size_t METAKV_BLK = 64 * 1024 * 2;
constexpr size_t WS_SSP = 67 * MiB;
constexpr size_t WS_UV6 = 70 * MiB;
constexpr size_t WS_SCL = 118 * MiB;
constexpr size_t WS_U6S = 120 * MiB, WS_V6S = 144 * MiB;
constexpr size_t WS_SELE = 168 * MiB;
constexpr size_t WS_SELG = 172 * MiB;
constexpr size_t WS_PW = 180 * MiB;
constexpr size_t WS_PART = 198 * MiB;
constexpr size_t WS_XN = 198 * MiB;
constexpr size_t WS_OC = WS_XN;
constexpr size_t WS_ODA = WS_XN, WS_ONA = 454 * MiB;
constexpr size_t WS_QDA = 262 * MiB, WS_KDA = 294 * MiB, WS_VDA = 326 * MiB, WS_QNA = 358 * MiB, WS_KNA = 390 * MiB, WS_VNA = 422 * MiB;
constexpr size_t WS_END = 486 * MiB;
constexpr size_t WS_Y1 = WS_QDA;
constexpr size_t WS_MIX = WS_VDA;
constexpr size_t WS_H2G = WS_KNA;
constexpr size_t WS_PQ = WS_QDA;
constexpr int CW_BAR = 4096, CW_QUEUE = 8192;

constexpr int RING_OFF = 0, RING_BYTES = 131072;
constexpr int LDSCTL_OFF = 143360, MISC_OFF = LDSCTL_OFF + 320;
constexpr int LDS_BYTES = 147456;
static_assert(MISC_OFF + 128 <= LDS_BYTES && att::LDS_BYTES <= LDSCTL_OFF && RING_BYTES <= LDSCTL_OFF, "LDS map");

#define GAS __attribute__((address_space(1)))
#define LAS __attribute__((address_space(3)))
typedef unsigned short bf16;
typedef unsigned v4u __attribute__((ext_vector_type(4)));
typedef unsigned v2u __attribute__((ext_vector_type(2)));
typedef float f32x4 __attribute__((ext_vector_type(4)));
typedef float f32x2 __attribute__((ext_vector_type(2)));
typedef float f32x16 __attribute__((ext_vector_type(16)));
typedef short bf16x8 __attribute__((ext_vector_type(8)));
typedef __bf16 bf16x2_t __attribute__((ext_vector_type(2)));
typedef GAS unsigned gu32;
#define RLX_AGENT __ATOMIC_RELAXED, __HIP_MEMORY_SCOPE_AGENT
#define LDS_WAIT() asm volatile("s_waitcnt lgkmcnt(0)" ::: "memory")
#define VM_WAIT() asm volatile("s_waitcnt vmcnt(0)" ::: "memory")
__device__ __forceinline__ unsigned f2bf(float f) { unsigned u = __builtin_bit_cast(unsigned, f); return (u + 0x7fffu + ((u >> 16) & 1u)) >> 16; }
__device__ __forceinline__ unsigned pk2(float lo, float hi) { return f2bf(lo) | (f2bf(hi) << 16); }

#define XB_TMO      128
#define XB_XCNT(j)  (256  + 64 * (j))
#define XB_XSUB(j)  (1280 + 64 * (j))
#define XB_XGEN(j)  (2304 + 64 * (j))
#define XB_TOP      3328
#define XB_TOPGEN   3392
#define XCD_BAR_WORDS 3456
#define XB_SPIN_CAP (1u << 22)

__device__ __forceinline__ unsigned xb_ld(unsigned* p)              { return __hip_atomic_load(p, __ATOMIC_RELAXED, __HIP_MEMORY_SCOPE_AGENT); }
__device__ __forceinline__ unsigned xb_add(unsigned* p, unsigned v) { return __hip_atomic_fetch_add(p, v, __ATOMIC_RELAXED, __HIP_MEMORY_SCOPE_AGENT); }
__device__ __forceinline__ unsigned xb_xcc_id() { return (unsigned)__builtin_amdgcn_s_getreg((3 << 11) | 20) & 0xFu; }
#define XB_SPIN(cond, bar) do { unsigned _sp = 0; while (cond) { __builtin_amdgcn_s_sleep(1); \
    if ((++_sp & 255u) == 0u) { if (xb_ld(&(bar)[XB_TMO])) break; if (_sp > XB_SPIN_CAP) { atomicAdd(&(bar)[XB_TMO], 1u); break; } } } } while (0)

struct XcdBarrier { unsigned* bar; unsigned x; volatile LAS unsigned* st; };

__device__ __forceinline__ XcdBarrier xcd_barrier_post(unsigned* bar, volatile LAS unsigned* st) {
    XcdBarrier b; b.bar = bar; b.x = xb_xcc_id(); b.st = st;
    if (threadIdx.x == 0) (void)xb_add(&bar[XB_XCNT(b.x)], 1u);
    return b;
}
__device__ __forceinline__ void xcd_barrier_complete(unsigned* bar, unsigned x, unsigned& nloc, unsigned& nx) {
    const unsigned G = gridDim.x * gridDim.y * gridDim.z;
    unsigned sum, cnt, mine, sp = 0u;
    for (;;) {
        sum = 0u; cnt = 0u; mine = 0u;
#pragma unroll
        for (unsigned j = 0; j < 16; ++j) { const unsigned c = xb_ld(&bar[XB_XCNT(j)]); sum += c; cnt += (c > 0u) ? 1u : 0u; mine = (j == x) ? c : mine; }
        if (sum == G) break;
        __builtin_amdgcn_s_sleep(1);
        if ((++sp & 255u) == 0u) { if (xb_ld(&bar[XB_TMO])) break; if (sp > XB_SPIN_CAP) { atomicAdd(&bar[XB_TMO], 1u); break; } }
    }
    nloc = mine > 0u ? mine : 1u; nx = cnt > 0u ? cnt : 1u;
}
__device__ __forceinline__ void xcd_barrier(const XcdBarrier& b) {
    asm volatile("s_waitcnt vmcnt(0)" ::: "memory");
    __syncthreads();
    if (threadIdx.x == 0) {
        unsigned* bar = b.bar;
        __builtin_amdgcn_s_waitcnt(0);
        unsigned nloc = b.st[0], nx = b.st[1];
        if (nloc == 0u) { xcd_barrier_complete(bar, b.x, nloc, nx); b.st[0] = nloc; b.st[1] = nx; }
        const unsigned old = xb_add(&bar[XB_XSUB(b.x)], 1u);
        const unsigned gen = old / nloc;
        if (old + 1u == (gen + 1u) * nloc) {
            __builtin_amdgcn_fence(__ATOMIC_RELEASE, "agent");
            asm volatile("s_waitcnt vmcnt(0)" ::: "memory");
            const unsigned og = xb_add(&bar[XB_TOP], 1u);
            const unsigned tg = og / nx;
            if (og + 1u == (tg + 1u) * nx) xb_add(&bar[XB_TOPGEN], 1u);
            else XB_SPIN(xb_ld(&bar[XB_TOPGEN]) == tg, bar);
            __builtin_amdgcn_fence(__ATOMIC_ACQUIRE, "agent");
            xb_add(&bar[XB_XGEN(b.x)], 1u);
            asm volatile("s_waitcnt vmcnt(0)" ::: "memory");
        } else {
            XB_SPIN(xb_ld(&bar[XB_XGEN(b.x)]) == gen, bar);
            __builtin_amdgcn_fence(__ATOMIC_ACQUIRE, "agent");
            asm volatile("s_waitcnt vmcnt(0)" ::: "memory");
        }
    }
    __syncthreads();
}

struct Frame {
    LAS unsigned char* lds;
    volatile LAS unsigned* MISC;
    int tid, lane, wave;
    int vcu, G;
};

__device__ __forceinline__ float wave_sum(float v) {
#pragma unroll
    for (int o = 1; o < 64; o <<= 1) v += __shfl_xor(v, o);
    return v;
}
__device__ __forceinline__ float wave_sum_dpp(float v) {
#define DPPF(x, ctrl, rmask, bc) __builtin_bit_cast(float, __builtin_amdgcn_update_dpp(0, __builtin_bit_cast(int, (x)), (ctrl), (rmask), 0xf, (bc)))
    v += DPPF(v, 0x111, 0xf, true); v += DPPF(v, 0x112, 0xf, true); v += DPPF(v, 0x114, 0xf, true); v += DPPF(v, 0x118, 0xf, true);
    v += DPPF(v, 0x142, 0xa, false);
    v += DPPF(v, 0x143, 0xc, false);
#undef DPPF
    return __builtin_bit_cast(float, __builtin_amdgcn_readlane(__builtin_bit_cast(int, v), 63));
}
__device__ __forceinline__ int win_row_of_col(int c) {
    const int pn = c >> 8, cc = c & 255;
    const bool normtile = (pn < 8) || (pn >= 12 && pn < 20);
    if (normtile) return (pn << 8) + 128 * ((cc >> 5) & 1) + 32 * (cc >> 6) + (cc & 31);
    return c;
}
template <bool PERMUTE>
__device__ __forceinline__ void p0_transpose_item(const float* W, int K, int N, bf16* WT, LAS float* scr, int item, int lane) {
    const int nblk = N / 32, kb = item / nblk, nb = item % nblk, k0 = 64 * kb, n0 = 32 * nb;
    const int r0 = PERMUTE ? win_row_of_col(n0) : n0;
#pragma unroll 8
    for (int i = 0; i < 32; ++i) { const int kk = 2 * i + (lane >> 5); scr[kk * 33 + (lane & 31)] = W[(size_t)(k0 + kk) * N + n0 + (lane & 31)]; }
    LDS_WAIT(); asm volatile("" ::: "memory");
    const int c = lane & 7;
#pragma unroll
    for (int j = 0; j < 4; ++j) { const int n = (lane >> 3) + 8 * j; const LAS float* s = scr + (8 * c) * 33 + n;
        v4u o; o.x = pk2(s[0 * 33], s[1 * 33]); o.y = pk2(s[2 * 33], s[3 * 33]); o.z = pk2(s[4 * 33], s[5 * 33]); o.w = pk2(s[6 * 33], s[7 * 33]);
        *(GAS v4u*)(WT + (size_t)(r0 + n) * K + k0 + 8 * c) = o; }
    LDS_WAIT(); asm volatile("" ::: "memory");
}
__device__ __forceinline__ void rms_row_to_bf16(const float* xrow, const float* g, bf16* orow, int lane) {
    const GAS f32x4* xr = (const GAS f32x4*)xrow + lane; const GAS f32x4* gr = (const GAS f32x4*)g + lane;
    f32x4 v[8]; float s = 0.f;
#pragma unroll
    for (int j = 0; j < 8; ++j) { v[j] = xr[64 * j]; s += (v[j].x * v[j].x + v[j].y * v[j].y) + (v[j].z * v[j].z + v[j].w * v[j].w); }
    const float rstd = __builtin_amdgcn_rsqf(wave_sum(s) * (1.f / DM) + EPS);
    GAS unsigned long long* o8 = (GAS unsigned long long*)orow + lane;
#pragma unroll
    for (int j = 0; j < 8; ++j) { const f32x4 gg = gr[64 * j];
        o8[64 * j] = (unsigned long long)pk2(v[j].x * rstd * gg.x, v[j].y * rstd * gg.y) | ((unsigned long long)pk2(v[j].z * rstd * gg.z, v[j].w * rstd * gg.w) << 32); }
}

typedef float f32x16v __attribute__((ext_vector_type(16)));
typedef float f32x32v __attribute__((ext_vector_type(32)));
typedef unsigned v6u __attribute__((ext_vector_type(6)));
__device__ __forceinline__ void fp6_row(const float* src, unsigned char* rec, float* scl, int lane) {
    f32x4 v[8]; float am = 0.f;
#pragma unroll
    for (int q = 0; q < 8; ++q) { v[q] = *(const GAS f32x4*)(src + 32 * lane + 4 * q);
        am = __builtin_fmaxf(am, __builtin_fmaxf(__builtin_fmaxf(__builtin_fabsf(v[q].x), __builtin_fabsf(v[q].y)), __builtin_fmaxf(__builtin_fabsf(v[q].z), __builtin_fabsf(v[q].w)))); }
#pragma unroll
    for (int o = 1; o < 64; o <<= 1) am = __builtin_fmaxf(am, __shfl_xor(am, o));
    am = __builtin_fmaxf(am, 1.0e-30f);
    const float sc = 7.5f / am;
    f32x16v lo, hi;
#pragma unroll
    for (int q = 0; q < 8; ++q) { lo[2 * q] = v[q].x * sc; hi[2 * q] = v[q].y * sc; lo[2 * q + 1] = v[q].z * sc; hi[2 * q + 1] = v[q].w * sc; }
    const v6u p = __builtin_amdgcn_cvt_scalef32_2xpk16_fp6_f32(lo, hi, 1.0f);
    *(GAS v4u*)(rec + lane * 16) = (v4u){p[0], p[1], p[2], p[3]};
    *(GAS v2u*)(rec + 1024 + lane * 8) = (v2u){p[4], p[5]};
    if (lane == 0) *scl = am * (1.0f / 7.5f);
}
__device__ __forceinline__ void fp6_row_sliced(const float* src, unsigned char* tab, int e, float* scl, int lane) {
    f32x4 v[8]; float am = 0.f;
#pragma unroll
    for (int q = 0; q < 8; ++q) { v[q] = *(const GAS f32x4*)(src + 32 * lane + 4 * q);
        am = __builtin_fmaxf(am, __builtin_fmaxf(__builtin_fmaxf(__builtin_fabsf(v[q].x), __builtin_fabsf(v[q].y)), __builtin_fmaxf(__builtin_fabsf(v[q].z), __builtin_fabsf(v[q].w)))); }
#pragma unroll
    for (int o = 1; o < 64; o <<= 1) am = __builtin_fmaxf(am, __shfl_xor(am, o));
    am = __builtin_fmaxf(am, 1.0e-30f);
    const float sc = 7.5f / am;
    f32x16v lo, hi;
#pragma unroll
    for (int q = 0; q < 8; ++q) { lo[2 * q] = v[q].x * sc; hi[2 * q] = v[q].y * sc; lo[2 * q + 1] = v[q].z * sc; hi[2 * q + 1] = v[q].w * sc; }
    const v6u p = __builtin_amdgcn_cvt_scalef32_2xpk16_fp6_f32(lo, hi, 1.0f);
    unsigned char* sl = tab + (size_t)(lane >> 3) * (16384 * 192);
    *(GAS v4u*)(sl + (size_t)e * 128 + (lane & 7) * 16) = (v4u){p[0], p[1], p[2], p[3]};
    *(GAS v2u*)(sl + 16384 * 128 + (size_t)e * 64 + (lane & 7) * 8) = (v2u){p[4], p[5]};
    if (lane == 0) *scl = am * (1.0f / 7.5f);
}
__device__ __forceinline__ void meta_proj(Frame& F, const bf16* XNM, const bf16* WinT, bf16* metakv, const float* gk_da, const float* gk_na, int j) {
    const int s = j >> 4, gi = j & 15;
    const int cbase = (s == 0) ? 1024 : (s == 1) ? 2048 : (s == 2) ? 4096 : 5120;
    const int c0 = cbase + 64 * gi;
    const int l15 = F.lane & 15, kq = F.lane >> 4, w = F.wave;
    f32x4 acc[4];
#pragma unroll
    for (int t = 0; t < 4; ++t) acc[t] = (f32x4){0.f, 0.f, 0.f, 0.f};
    const bf16* ap = XNM + (size_t)l15 * 2048 + 256 * w + 8 * kq;
    const bf16* bp[4];
#pragma unroll
    for (int t = 0; t < 4; ++t) bp[t] = WinT + (size_t)win_row_of_col(c0 + 16 * t + l15) * 2048 + 256 * w + 8 * kq;
#pragma unroll
    for (int ks = 0; ks < 8; ++ks) { const bf16x8 a = *(const GAS bf16x8*)(ap + 32 * ks);
#pragma unroll
        for (int t = 0; t < 4; ++t) { const bf16x8 b = *(const GAS bf16x8*)(bp[t] + 32 * ks); acc[t] = __builtin_amdgcn_mfma_f32_16x16x32_bf16(a, b, acc[t], 0, 0, 0); } }
    LAS float* part = (LAS float*)(F.lds + RING_OFF);
    LAS float* res = part + 8 * 16 * 64;
#pragma unroll
    for (int t = 0; t < 4; ++t)
#pragma unroll
        for (int r = 0; r < 4; ++r) part[(w * 16 + 4 * kq + r) * 64 + 16 * t + l15] = acc[t][r];
    __syncthreads();
#pragma unroll
    for (int q = 0; q < 2; ++q) { const int o = F.tid * 2 + q; float v = 0.f;
#pragma unroll
        for (int ww = 0; ww < 8; ++ww) v += part[ww * 1024 + o];
        res[o] = v; }
    __syncthreads();
    { const int token = 2 * w + (F.lane >> 5), cc = 2 * (F.lane & 31);
      float v0 = res[token * 64 + cc], v1 = res[token * 64 + cc + 1];
      if (s == 0 || s == 2) { float ss = v0 * v0 + v1 * v1;
#pragma unroll
          for (int o = 1; o < 32; o <<= 1) ss += __shfl_xor(ss, o);
          const float rs = __builtin_amdgcn_rsqf(ss * (1.0f / 64.0f) + EPS); const float* g = (s == 0) ? gk_da : gk_na;
          v0 *= rs * g[cc]; v1 *= rs * g[cc + 1]; }
      bf16* dst = metakv + (size_t)s * (64 * 1024) + (size_t)(48 + token) * 1024 + 64 * gi + cc;
      *(GAS unsigned*)dst = pk2(v0, v1); }
    __syncthreads();
}

__device__ __forceinline__ int f2ord(float f) { const int i = __builtin_bit_cast(int, f); return i ^ ((i >> 31) & 0x7fffffff); }
__device__ __forceinline__ float ord2f(int i) { return __builtin_bit_cast(float, i ^ ((i >> 31) & 0x7fffffff)); }
#define TOPK_INS(L, x) do { int v_ = (x); _Pragma("unroll") for (int i_ = 0; i_ < 16; ++i_) { const int t_ = max(L[i_], v_); v_ = min(L[i_], v_); L[i_] = t_; } } while (0)
__device__ __forceinline__ float gelu_tanh(float a) {
    const float z = 0.7978845608028654f * (a + 0.044715f * a * a * a);
    const float e = __builtin_amdgcn_exp2f(z * (2.0f * LOG2E));
    const float th = 1.0f - 2.0f * __builtin_amdgcn_rcpf(e + 1.0f);
    return 0.5f * a * (1.0f + th);
}
constexpr int PEER_TOK = 32;
constexpr int PL_SELE = 0, PL_SELG = 8192, PL_SET = 24576, PL_IDX = 2 * PL_SET;

#define CE_DESC(a, b) do { const int hi_ = max((a), (b)); const int lo_ = min((a), (b)); (a) = hi_; (b) = lo_; } while (0)
__device__ __forceinline__ void sort16_desc(int (&v)[16]) {
#pragma unroll
    for (int k = 2; k <= 16; k <<= 1)
#pragma unroll
        for (int j = k >> 1; j > 0; j >>= 1)
#pragma unroll
            for (int i = 0; i < 16; ++i) { const int l = i ^ j; if (l > i) { if ((i & k) == 0) CE_DESC(v[i], v[l]); else CE_DESC(v[l], v[i]); } }
}
__device__ __forceinline__ void merge16_desc(int (&a)[16], const int (&b)[16]) {
#pragma unroll
    for (int i = 0; i < 16; ++i) a[i] = max(a[i], b[15 - i]);
#pragma unroll
    for (int j = 8; j > 0; j >>= 1)
#pragma unroll
        for (int i = 0; i < 16; ++i) { const int l = i ^ j; if (l > i) CE_DESC(a[i], a[l]); }
}
__device__ __forceinline__ void peer_retrieve(Frame& F, const bf16* PQ, const bf16* SK, unsigned short* SELE, float* SELG, int tile) {
    const int t0 = tile * PEER_TOK, lane = F.lane, r32 = lane & 31, hi = lane >> 5, h = F.wave;
    int L0[16], L1[16];
    int hi4 = 4 * hi; asm volatile("" : "+v"(hi4));
#pragma unroll
    for (int p = 0; p < 2; ++p) {
        f32x16 acc[4];
#pragma unroll
        for (int rt = 0; rt < 4; ++rt)
#pragma unroll
            for (int r = 0; r < 16; ++r) acc[rt][r] = 0.f;
        const bf16* qp = PQ + (size_t)(t0 + r32) * 2048 + h * 256 + p * 128 + hi * 8;
        const bf16* skp = SK + (size_t)p * 16384 + (size_t)r32 * 128 + hi * 8;
        asm volatile("" : "+v"(qp), "+v"(skp));
#pragma unroll
        for (int ks = 0; ks < 8; ++ks) { const bf16x8 bq = *(const GAS bf16x8*)(qp + 16 * ks);
#pragma unroll
            for (int rt = 0; rt < 4; ++rt) { const bf16x8 a = *(const GAS bf16x8*)(skp + rt * 4096 + 16 * ks); acc[rt] = __builtin_amdgcn_mfma_f32_32x32x16_bf16(a, bq, acc[rt], 0, 0, 0); } }
        int L[16];
        {
            int G1[16], G2[16], G3[16];
#pragma unroll
            for (int r = 0; r < 16; ++r) {
                L[r] = ((f2ord(acc[0][r]) & ~127) | hi4) | (0 + (r & 3) + 8 * (r >> 2)); G1[r] = ((f2ord(acc[1][r]) & ~127) | hi4) | (32 + (r & 3) + 8 * (r >> 2));
                G2[r] = ((f2ord(acc[2][r]) & ~127) | hi4) | (64 + (r & 3) + 8 * (r >> 2)); G3[r] = ((f2ord(acc[3][r]) & ~127) | hi4) | (96 + (r & 3) + 8 * (r >> 2)); }
            sort16_desc(L); sort16_desc(G1); merge16_desc(L, G1);
            sort16_desc(G2); sort16_desc(G3); merge16_desc(G2, G3);
            merge16_desc(L, G2);
        }
        int O[16];
#pragma unroll
        for (int i = 0; i < 16; ++i) O[i] = __shfl_xor(L[i], 32);
        merge16_desc(L, O);
#pragma unroll
        for (int i = 0; i < 16; ++i) { if (p == 0) L0[i] = L[i]; else L1[i] = L[i]; }
    }
    int C[16];
#define CKEY(i_, j_) ((f2ord(ord2f(L0[i_] & ~127) + ord2f(L1[j_] & ~127)) & ~255) | ((i_) << 4) | (15 - (j_)))
    {
#pragma unroll
        for (int j = 0; j < 16; ++j) C[j] = CKEY(0, j);
#pragma unroll
        for (int j = 8; j < 16; ++j) C[j] = max(C[j], CKEY(1, 15 - j));
#pragma unroll
        for (int jj = 8; jj > 0; jj >>= 1)
#pragma unroll
            for (int i = 0; i < 16; ++i) { const int l = i ^ jj; if (l > i) CE_DESC(C[i], C[l]); }
        int X[16] = {CKEY(2, 0), CKEY(2, 1), CKEY(2, 2), CKEY(2, 3), CKEY(2, 4), CKEY(3, 0), CKEY(3, 1), CKEY(3, 2), CKEY(3, 3), CKEY(4, 0), CKEY(4, 1), CKEY(4, 2), CKEY(5, 0), CKEY(5, 1), CKEY(6, 0), CKEY(6, 1)};
        sort16_desc(X); merge16_desc(C, X);
        int Y[16] = {CKEY(7, 0), CKEY(7, 1), CKEY(8, 0), CKEY(9, 0), CKEY(10, 0), CKEY(11, 0), CKEY(12, 0), CKEY(13, 0), CKEY(14, 0), CKEY(15, 0),
                     (int)0x80000000, (int)0x80000000, (int)0x80000000, (int)0x80000000, (int)0x80000000, (int)0x80000000};
        sort16_desc(Y); merge16_desc(C, Y);
    }
#undef CKEY
    LAS unsigned* ix = (LAS unsigned*)(F.lds + PL_IDX + F.tid * 32);
#pragma unroll
    for (int q = 0; q < 4; ++q) {
        ix[q] = (unsigned)(L0[4 * q] & 127) | ((unsigned)(L0[4 * q + 1] & 127) << 8) | ((unsigned)(L0[4 * q + 2] & 127) << 16) | ((unsigned)(L0[4 * q + 3] & 127) << 24);
        ix[4 + q] = (unsigned)(L1[4 * q] & 127) | ((unsigned)(L1[4 * q + 1] & 127) << 8) | ((unsigned)(L1[4 * q + 2] & 127) << 16) | ((unsigned)(L1[4 * q + 3] & 127) << 24); }
    const LAS unsigned char* ixb = (const LAS unsigned char*)ix;
    float sc[16]; float sum = 0.f;
#pragma unroll
    for (int k = 0; k < 16; ++k) sc[k] = ord2f(C[k] & ~255);
    const float mx = sc[0];
#pragma unroll
    for (int k = 0; k < 16; ++k) { sc[k] = __builtin_amdgcn_exp2f((sc[k] - mx) * LOG2E); sum += sc[k]; }
    const float rsum = 1.0f / sum;
    if (hi == 0) {
        unsigned ew[8];
#pragma unroll
        for (int k = 0; k < 16; ++k) { const int ij = C[k] & 255; const unsigned e = (unsigned)ixb[ij >> 4] * 128u + (unsigned)ixb[16 + (15 - (ij & 15))];
            if (k & 1) ew[k >> 1] |= e << 16; else ew[k >> 1] = e; }
        GAS v4u* ep = (GAS v4u*)(SELE + (size_t)(t0 + r32) * 128 + h * 16);
        ep[0] = (v4u){ew[0], ew[1], ew[2], ew[3]}; ep[1] = (v4u){ew[4], ew[5], ew[6], ew[7]};
        GAS f32x4* gp = (GAS f32x4*)(SELG + (size_t)(t0 + r32) * 128 + h * 16);
#pragma unroll
        for (int q = 0; q < 4; ++q) gp[q] = (f32x4){sc[4 * q] * rsum, sc[4 * q + 1] * rsum, sc[4 * q + 2] * rsum, sc[4 * q + 3] * rsum};
    }
}

typedef float f32x2v __attribute__((ext_vector_type(2)));
template <int PASS>
__device__ __forceinline__ void peer_slice_pass(Frame& F, const unsigned char* TAB, const unsigned short* SELE, const float* PW, const bf16* H2G, float* PART, const float* g2, float* OUT) {
    const int x = (int)(blockIdx.x & 7), jb = (int)(blockIdx.x >> 3), JB = (F.G - x + 7) >> 3;
    const int lane = F.lane, grp = lane >> 3, s = lane & 7;
    LAS unsigned char* wl = F.lds + F.wave * 8192;
    const LAS unsigned short* LE = (const LAS unsigned short*)wl + grp * 128; LAS float* LW = (LAS float*)(wl + 2048) + grp * 128;
    const unsigned char* tab = TAB + (size_t)x * (16384 * 192);
    const unsigned o16 = 16u * s, o8 = 16384u * 128u + 8u * s;
#define DPPF(xx, ctrl) __builtin_bit_cast(float, __builtin_amdgcn_update_dpp(0, __builtin_bit_cast(int, (xx)), (ctrl), 0xf, 0xf, true))
#define PS_ISSUE(g_, A, B, W4) do { const v2u ids_ = *(const LAS v2u*)(LE + 4 * (g_)); if (PASS == 1) W4 = *(const LAS f32x4*)(LW + 4 * (g_)); \
        const unsigned e0_ = (ids_.x & 0xffffu) * 64u, e1_ = (ids_.x >> 16) * 64u, e2_ = (ids_.y & 0xffffu) * 64u, e3_ = (ids_.y >> 16) * 64u; \
        A[0] = *(const GAS v4u*)(tab + (2u * e0_ + o16)); B[0] = *(const GAS v2u*)(tab + (e0_ + o8)); A[1] = *(const GAS v4u*)(tab + (2u * e1_ + o16)); B[1] = *(const GAS v2u*)(tab + (e1_ + o8)); \
        A[2] = *(const GAS v4u*)(tab + (2u * e2_ + o16)); B[2] = *(const GAS v2u*)(tab + (e2_ + o8)); A[3] = *(const GAS v4u*)(tab + (2u * e3_ + o16)); B[3] = *(const GAS v2u*)(tab + (e3_ + o8)); } while (0)
#pragma unroll 1
    for (int tb = jb * NWAVES + F.wave; tb < M / 8; tb += JB * NWAVES) {
        const size_t t = (size_t)tb * 8 + grp;
        { const GAS v4u* sp = (const GAS v4u*)(SELE + (size_t)tb * 1024) + lane * 2; const v4u a = sp[0], b = sp[1];
          *(LAS v4u*)(wl + lane * 32) = a; *(LAS v4u*)(wl + lane * 32 + 16) = b; }
        if (PASS == 1) { const GAS f32x4* wp = (const GAS f32x4*)(PW + (size_t)tb * 1024) + lane * 4;
#pragma unroll
            for (int q = 0; q < 4; ++q) *(LAS f32x4*)(wl + 2048 + lane * 64 + 16 * q) = wp[q]; }
        const bf16* xp = H2G + t * 2048 + 256 * x + 32 * s;
        f32x2v xv[16];
        if (PASS == 0) {
#pragma unroll
            for (int q = 0; q < 4; ++q) { const v4u w = *(const GAS v4u*)(xp + 8 * q);
                xv[4 * q] = (f32x2v){pg8::bf_lo(w.x), pg8::bf_hi(w.x)}; xv[4 * q + 1] = (f32x2v){pg8::bf_lo(w.y), pg8::bf_hi(w.y)};
                xv[4 * q + 2] = (f32x2v){pg8::bf_lo(w.z), pg8::bf_hi(w.z)}; xv[4 * q + 3] = (f32x2v){pg8::bf_lo(w.w), pg8::bf_hi(w.w)}; }
        } else {
#pragma unroll
            for (int j = 0; j < 16; ++j) xv[j] = (f32x2v){0.f, 0.f};
        }
        asm volatile("" ::: "memory");
        v4u a0[4], a1[4]; v2u b0[4], b1[4]; f32x4 w0, w1;
        PS_ISSUE(0, a0, b0, w0);
        __builtin_amdgcn_sched_barrier(0);
#pragma unroll 1
        for (int g = 0; g < 32; g += 2) {
            PS_ISSUE(g + 1, a1, b1, w1);
            __builtin_amdgcn_sched_barrier(0);
#pragma unroll
            for (int half = 0; half < 2; ++half) {
                float d[4];
#pragma unroll
                for (int i = 0; i < 4; ++i) {
                    const v4u A = half ? a1[i] : a0[i]; const v2u B = half ? b1[i] : b0[i];
                    const f32x32v r = __builtin_amdgcn_cvt_scalef32_pk32_f32_fp6((v6u){A.x, A.y, A.z, A.w, B.x, B.y}, 1.0f);
                    if (PASS == 0) {
                        f32x2v p0 = (f32x2v){0.f, 0.f}, p1 = p0, p2 = p0, p3 = p0;
#pragma unroll
                        for (int j = 0; j < 16; j += 4) {
                            p0 = __builtin_elementwise_fma((f32x2v){r[2 * j], r[2 * j + 1]}, xv[j], p0); p1 = __builtin_elementwise_fma((f32x2v){r[2 * j + 2], r[2 * j + 3]}, xv[j + 1], p1);
                            p2 = __builtin_elementwise_fma((f32x2v){r[2 * j + 4], r[2 * j + 5]}, xv[j + 2], p2); p3 = __builtin_elementwise_fma((f32x2v){r[2 * j + 6], r[2 * j + 7]}, xv[j + 3], p3); }
                        const f32x2v ps = (p0 + p1) + (p2 + p3);
                        d[i] = ps.x + ps.y;
                    } else {
                        const float w = half ? w1[i] : w0[i]; const f32x2v ww = (f32x2v){w, w};
#pragma unroll
                        for (int j = 0; j < 16; ++j) xv[j] = __builtin_elementwise_fma(ww, (f32x2v){r[2 * j], r[2 * j + 1]}, xv[j]);
                    }
                }
                if (PASS == 0) {
#pragma unroll
                    for (int i = 0; i < 4; ++i) d[i] += DPPF(d[i], 0xB1);
#pragma unroll
                    for (int i = 0; i < 4; ++i) d[i] += DPPF(d[i], 0x4E);
#pragma unroll
                    for (int i = 0; i < 4; ++i) d[i] += DPPF(d[i], 0x141);
                    if (s == 0) *(LAS f32x4*)(LW + 4 * (g + half)) = (f32x4){d[0], d[1], d[2], d[3]};
                }
                if (half == 0) { __builtin_amdgcn_sched_barrier(0); PS_ISSUE((g + 2) & 31, a0, b0, w0); __builtin_amdgcn_sched_barrier(0); }
            }
        }
        asm volatile("" ::: "memory");
        if (PASS == 0) {
            GAS f32x4* pp = (GAS f32x4*)(PART + ((size_t)x * M + (size_t)tb * 8) * 128) + lane;
#pragma unroll
            for (int q = 0; q < 4; ++q) __builtin_nontemporal_store(*(const LAS f32x4*)(wl + 2048 + (q * 64 + lane) * 16), pp + q * 64);
        } else {
#pragma unroll
            for (int j = 0; j < 8; ++j) *(LAS f32x4*)(wl + lane * 128 + 16 * j) = (f32x4){xv[2 * j].x, xv[2 * j].y, xv[2 * j + 1].x, xv[2 * j + 1].y};
            asm volatile("" ::: "memory");
#pragma unroll
            for (int q = 0; q < 8; ++q) { const f32x4 a = *(const LAS f32x4*)(wl + (grp * 8 + q) * 128 + 16 * s);
                const size_t c0 = t * 2048 + 256 * x + 32 * q + 4 * s; const v2u w = *(const GAS v2u*)(H2G + c0); const f32x4 gq = *(const GAS f32x4*)(g2 + 256 * x + 32 * q + 4 * s);
                __builtin_nontemporal_store((f32x4){pg8::bf_lo(w.x) * __builtin_amdgcn_rcpf(gq[0]) + a[0], pg8::bf_hi(w.x) * __builtin_amdgcn_rcpf(gq[1]) + a[1],
                                                    pg8::bf_lo(w.y) * __builtin_amdgcn_rcpf(gq[2]) + a[2], pg8::bf_hi(w.y) * __builtin_amdgcn_rcpf(gq[3]) + a[3]}, (GAS f32x4*)(OUT + c0)); }
        }
        asm volatile("" ::: "memory");
    }
#undef PS_ISSUE
#undef DPPF
}

struct Args { const float* in[22]; float* out; unsigned char* ws; int ph_lo, ph_hi, li, pad; };
__global__ void __launch_bounds__(NWAVES * 64, 2) mk_fwd(Args args) {
    extern __shared__ __attribute__((aligned(16))) unsigned char lds[];
    Frame F;
    F.lds = (LAS unsigned char*)lds;
    F.MISC = (volatile LAS unsigned*)(F.lds + MISC_OFF);
    F.tid = threadIdx.x; F.lane = F.tid & 63; F.wave = __builtin_amdgcn_readfirstlane(F.tid >> 6);
    F.G = gridDim.x; { const int bx = blockIdx.x; F.vcu = (F.G % 8 == 0) ? (bx % 8) * (F.G / 8) + bx / 8 : bx; }
    unsigned char* ws = args.ws;
    gu32* ctl = (gu32*)(ws + WS_CTL);
    const float* x = args.in[0]; const float* meta_tok = args.in[1]; const float* g1 = args.in[2]; const float* w_in = args.in[3];
    const float* gq_da = args.in[4]; const float* gk_da = args.in[5];
    const float* lq1 = args.in[6]; const float* lk1 = args.in[7]; const float* lq2 = args.in[8]; const float* lk2 = args.in[9];
    const float* g_oda = args.in[10]; const float* gq_na = args.in[11]; const float* gk_na = args.in[12]; const float* rpb = args.in[13];
    const float* w_bda = args.in[14]; const float* w_bna = args.in[15]; const float* w_out = args.in[16]; const float* g2 = args.in[17];
    const float* w_pq = args.in[18]; const float* subk = args.in[19]; const float* pu = args.in[20]; const float* pv = args.in[21];
    float* OUT = args.out;
    bf16* WinT = (bf16*)(ws + WS_WIN_T); bf16* WbdaT = (bf16*)(ws + WS_WBDA_T); bf16* WbnaT = (bf16*)(ws + WS_WBNA_T); bf16* WoutT = (bf16*)(ws + WS_WOUT_T); bf16* WqT = (bf16*)(ws + WS_WQ_T);
    bf16* SK = (bf16*)(ws + WS_SK); bf16* XNM = (bf16*)(ws + WS_XNM); bf16* METAKV = (bf16*)(ws + WS_METAKV); float* SSP = (float*)(ws + WS_SSP);
    unsigned char* U6S = ws + WS_U6S; unsigned char* V6S = ws + WS_V6S; unsigned short* SELE = (unsigned short*)(ws + WS_SELE); float* SELG = (float*)(ws + WS_SELG); float* PW = (float*)(ws + WS_PW); float* PART = (float*)(ws + WS_PART);
    float* SCL = (float*)(ws + WS_SCL); bf16* XN = (bf16*)(ws + WS_XN); bf16* ODA = (bf16*)(ws + WS_ODA); bf16* ONA = (bf16*)(ws + WS_ONA); bf16* OC = (bf16*)(ws + WS_OC);
    bf16* QDA = (bf16*)(ws + WS_QDA); bf16* KDA = (bf16*)(ws + WS_KDA); bf16* VDA = (bf16*)(ws + WS_VDA); bf16* QNA = (bf16*)(ws + WS_QNA); bf16* KNA = (bf16*)(ws + WS_KNA); bf16* VNA = (bf16*)(ws + WS_VNA);
    bf16* Y1 = (bf16*)(ws + WS_Y1); bf16* MIX = (bf16*)(ws + WS_MIX); bf16* H2G = (bf16*)(ws + WS_H2G); bf16* PQ = (bf16*)(ws + WS_PQ);
    bf16* SGDA = (bf16*)OUT; bf16* SGNA = (bf16*)OUT + (size_t)M * 2048;

    for (int u = F.tid; u < (LDS_BYTES - LDSCTL_OFF) / 4; u += NWAVES * 64) ((LAS unsigned*)(F.lds + LDSCTL_OFF))[u] = 0u;
    __syncthreads();
    XcdBarrier bar; bar.bar = (unsigned*)(ctl + CW_BAR); bar.x = 0; bar.st = nullptr;
    if (N_LAUNCHES == 1) bar = xcd_barrier_post((unsigned*)(ctl + CW_BAR), F.MISC + 8);
#define GRID_BAR() do { if (N_LAUNCHES == 1) xcd_barrier(bar); } while (0)
    const int lo = args.ph_lo, hi = args.ph_hi;
#ifndef PH_MASK
#define PH_MASK 0x7ff
#endif
#define IN(k) (((PH_MASK >> (k)) & 1) && lo <= (k) && (k) < hi)
#define BOTH(k) (IN(k) && IN((k) + 1))

    if (IN(0)) {
        LAS float* scr = (LAS float*)(F.lds + RING_OFF + F.wave * 16384);
        const int gw = F.vcu * NWAVES + F.wave, NGW = F.G * NWAVES;
        constexpr int I_IN = (DM / 64) * (INCOLS / 32);
        for (int it = gw; it < I_IN; it += NGW) p0_transpose_item<true>(w_in, DM, INCOLS, WinT, scr, it, F.lane);
        for (int m = gw; m < M + NMETA; m += NGW) {
            if (m < M) rms_row_to_bf16(x + (size_t)m * DM, g1, XN + (size_t)m * DM, F.lane);
            else rms_row_to_bf16(meta_tok + (size_t)(m - M) * DM, g1, XNM + (size_t)(m - M) * DM, F.lane);
        }
        const size_t gtid = (size_t)F.vcu * (NWAVES * 64) + F.tid, gthreads = (size_t)F.G * (NWAVES * 64);
        for (size_t i = gtid; i < (size_t)4 * 48 * 128; i += gthreads) {
            const size_t blk = i / (48 * 128), rem = i % (48 * 128);
            *(GAS v4u*)(METAKV + blk * (64 * 1024) + rem * 8) = (v4u){0u, 0u, 0u, 0u};
        }
        if (BOTH(0)) GRID_BAR();
    }

    if (IN(1)) {
        if (F.vcu < 64) meta_proj(F, XNM, WinT, METAKV, gk_da, gk_na, F.vcu);
        pg8::Gemm g{XN, WinT, M, INCOLS, DM}; pg8::StaticOrder S; S.init(M, INCOLS, F.G, (int)blockIdx.x);
        pg8::EpiIn E{QDA, KDA, VDA, QNA, KNA, VNA, SGDA, SGNA, gq_da, gk_da, gq_na, gk_na};
        pg8::gemm_phase<pg8::EpiIn, pg8::StaticOrder, true, true>(F.lds + RING_OFF, g, S, E);
        if (BOTH(1)) GRID_BAR();
    }

    if (IN(2)) {
        const unsigned lds0 = (unsigned)(uintptr_t)lds;
        float Sb;
        { float a = __builtin_fabsf(gq_da[F.lane]), b = __builtin_fabsf(gk_da[F.lane]);
#pragma unroll
          for (int o = 1; o < 64; o <<= 1) { a = __builtin_fmaxf(a, __shfl_xor(a, o)); b = __builtin_fmaxf(b, __shfl_xor(b, o)); }
          Sb = 8.0f * a * b * 1.02f; }
        const att::DAParams DP{QDA, KDA, VDA, METAKV, METAKV + 64 * 1024, OC, Sb * LOG2E - 8.0f};
        const att::NAParams NP{QNA, KNA, VNA, METAKV + 2 * 64 * 1024, METAKV + 3 * 64 * 1024, ONA, rpb};
        volatile LAS unsigned* qslot = F.MISC + 16;
        for (;;) {
            if (F.tid == 0) *qslot = __hip_atomic_fetch_add((unsigned*)(ctl + CW_QUEUE), 1u, __ATOMIC_RELAXED, __HIP_MEMORY_SCOPE_AGENT);
            __syncthreads();
            const int u = (int)*qslot;
            __syncthreads();
            if (u >= 2048) break;
            const int grp = u >> 2, pos = u & 3;
            if (pos == 3) {
                int ln = F.lane, tdx = F.tid; asm volatile("" : "+v"(ln), "+v"(tdx));
#pragma unroll 1
                for (int i = 0; i < 8; ++i) { const int r = grp * 64 + F.wave * 8 + i, e = r >> 1, isv = r & 1;
                    fp6_row_sliced((isv ? pv : pu) + (size_t)e * 2048, isv ? V6S : U6S, e, SCL + 2 * e + isv, ln); }
                constexpr int I_B = (1024 / 64) * (DM / 32), I_O = (DM / 64) * (DM / 32);
                LAS float* scr = (LAS float*)(F.lds + RING_OFF + F.wave * 16384);
#pragma unroll 1
                for (int i = F.wave; i < 12; i += NWAVES) { int r = grp * 12 + i;
                    if (r < I_B) { p0_transpose_item<false>(w_bda, 1024, DM, WbdaT, scr, r, ln); continue; } r -= I_B;
                    if (r < I_B) { p0_transpose_item<false>(w_bna, 1024, DM, WbnaT, scr, r, ln); continue; } r -= I_B;
                    if (r < I_O) { p0_transpose_item<false>(w_out, DM, DM, WoutT, scr, r, ln); continue; } r -= I_O;
                    p0_transpose_item<false>(w_pq, DM, DM, WqT, scr, r, ln); }
                if (tdx < 8) { const size_t i = (size_t)grp * 64 + tdx * 8;
                    const f32x4 a = *(const GAS f32x4*)(subk + i), b = *(const GAS f32x4*)(subk + i + 4);
                    v4u o; o.x = pk2(a.x, a.y); o.y = pk2(a.z, a.w); o.z = pk2(b.x, b.y); o.w = pk2(b.z, b.w);
                    *(GAS v4u*)(SK + i) = o; }
                VM_WAIT(); __syncthreads();
                continue;
            }
            const int ua = 3 * grp + pos;
            if (ua < 512) {
                const int h = 7 - (ua >> 6), r = ua & 63, b = r >> 5, qb = r & 31;
                const float slope = __builtin_amdgcn_exp2f(-(float)(h + 1));
                const float Df = (2.0f * Sb + 32.0f * 0.6931472f + __logf(2.0f * (1.0f / slope + 1.0f))) / slope;
                const int D = Df > 16384.0f ? 16384 : (int)Df + 1;
                const int qlo = 16 + 256 * qb, qhi = qlo + 255;
                int Tlo = (qlo - D <= 15) ? 0 : (qlo - D - 15 + 63) / 64;
                int Thi = (qhi + D + 48) / 64; if (Thi > 128) Thi = 128;
#pragma unroll 1
                for (int c = 0; c < 2; ++c) att::da_unit((ATT_LAS char*)F.lds, lds0, DP, b, h, c, qb, Tlo, Thi);
                __syncthreads();
                { int tdx = F.tid; asm volatile("" : "+v"(tdx));
                  const int sub = tdx & 7; float lam;
                  { const int ln = tdx & 63; const float a = lq1[ln] * lk1[ln], b2 = lq2[ln] * lk2[ln]; lam = expf(wave_sum(a)) - expf(wave_sum(b2)) + 0.2f; }
#pragma unroll 1
                  for (int rr = tdx >> 3; rr < 256; rr += 64) {
                    const size_t eo = ((size_t)b * SEQ + (size_t)qb * 256 + rr) * 1024 + h * 128 + sub * 16;
                    const bf16* p0 = OC + eo; const bf16* p1 = p0 + (size_t)M * 1024;
                    const v4u a0 = *(const GAS v4u*)p0, a1 = *(const GAS v4u*)(p0 + 8), b0 = *(const GAS v4u*)p1, b1 = *(const GAS v4u*)(p1 + 8);
                    float o[16];
#define CMB(i, A, Bv) o[2 * (i)] = pg8::bf_lo(A) - lam * pg8::bf_lo(Bv); o[2 * (i) + 1] = pg8::bf_hi(A) - lam * pg8::bf_hi(Bv);
                    CMB(0, a0.x, b0.x) CMB(1, a0.y, b0.y) CMB(2, a0.z, b0.z) CMB(3, a0.w, b0.w) CMB(4, a1.x, b1.x) CMB(5, a1.y, b1.y) CMB(6, a1.z, b1.z) CMB(7, a1.w, b1.w)
#undef CMB
                    float ss = 0.f;
#pragma unroll
                    for (int i = 0; i < 16; ++i) ss += o[i] * o[i];
                    ss += __shfl_xor(ss, 1); ss += __shfl_xor(ss, 2); ss += __shfl_xor(ss, 4);
                    const float rs = __builtin_amdgcn_rsqf(ss * (1.0f / 128.0f) + EPS) * 0.8f;
                    f32x4 gv[4];
#pragma unroll
                    for (int i = 0; i < 4; ++i) gv[i] = *(const GAS f32x4*)(g_oda + sub * 16 + 4 * i);
                    v4u w0, w1;
                    w0.x = pk2(o[0] * rs * gv[0][0], o[1] * rs * gv[0][1]); w0.y = pk2(o[2] * rs * gv[0][2], o[3] * rs * gv[0][3]);
                    w0.z = pk2(o[4] * rs * gv[1][0], o[5] * rs * gv[1][1]); w0.w = pk2(o[6] * rs * gv[1][2], o[7] * rs * gv[1][3]);
                    w1.x = pk2(o[8] * rs * gv[2][0], o[9] * rs * gv[2][1]); w1.y = pk2(o[10] * rs * gv[2][2], o[11] * rs * gv[2][3]);
                    w1.z = pk2(o[12] * rs * gv[3][0], o[13] * rs * gv[3][1]); w1.w = pk2(o[14] * rs * gv[3][2], o[15] * rs * gv[3][3]);
                    *(GAS v4u*)(ODA + eo) = w0; *(GAS v4u*)(ODA + eo + 8) = w1;
                  }
                  VM_WAIT(); __syncthreads(); }
            } else {
                const int v = ua - 512, bh = v >> 5;
                att::na_unit((ATT_LAS char*)F.lds, lds0, NP, bh >> 4, bh & 15, v & 31);
            }
        }
        if (BOTH(2)) GRID_BAR();
    }


    if (IN(4)) {
        { pg8::Gemm g{ODA, WbdaT, M, DM, 1024}; pg8::StaticOrder S; S.init(M, DM, F.G, (int)blockIdx.x);
          pg8::EpiGate<0> E{SGDA, nullptr, Y1};
          pg8::gemm_phase<pg8::EpiGate<0>, pg8::StaticOrder, true, true>(F.lds + RING_OFF, g, S, E); }
        VM_WAIT(); __syncthreads();
        { pg8::Gemm g{ONA, WbnaT, M, DM, 1024}; pg8::StaticOrder S; S.init(M, DM, F.G, (int)blockIdx.x);
          pg8::EpiGate<1> E{SGNA, Y1, MIX};
          pg8::gemm_phase<pg8::EpiGate<1>, pg8::StaticOrder, true, true>(F.lds + RING_OFF, g, S, E); }
        if (BOTH(4)) GRID_BAR();
    }

    if (IN(5)) {
        pg8::Gemm g{MIX, WoutT, M, DM, DM}; pg8::StaticOrder S; S.init(M, DM, F.G, (int)blockIdx.x);
        pg8::EpiOut E{x, OUT, H2G, g2, SSP};
        pg8::gemm_phase<pg8::EpiOut, pg8::StaticOrder, true, true>(F.lds + RING_OFF, g, S, E);
        if (BOTH(5)) GRID_BAR();
    }

    if (IN(6)) {
        pg8::Gemm g{H2G, WqT, M, DM, DM}; pg8::StaticOrder S; S.init(M, DM, F.G, (int)blockIdx.x);
        pg8::EpiPQ E{PQ, SSP};
        pg8::gemm_phase<pg8::EpiPQ, pg8::StaticOrder, true, true>(F.lds + RING_OFF, g, S, E);
        if (BOTH(6)) GRID_BAR();
    }

    if (IN(7)) {
#pragma unroll 1
        for (int tile = (int)blockIdx.x; tile < M / PEER_TOK; tile += F.G) peer_retrieve(F, PQ, SK, SELE, SELG, tile);
        if (BOTH(7)) GRID_BAR();
    }
    if (IN(8)) {
        peer_slice_pass<0>(F, U6S, SELE, nullptr, H2G, PART, g2, OUT);
        if (BOTH(8)) GRID_BAR();
    }
    if (IN(9)) {
        for (size_t idx = (size_t)blockIdx.x * (NWAVES * 64) + F.tid; idx < (size_t)M * 32; idx += (size_t)F.G * (NWAVES * 64)) {
            const size_t t = idx >> 5; const int k4 = (int)(idx & 31) * 4;
            f32x4 sum = *(const GAS f32x4*)(PART + t * 128 + k4);
#pragma unroll
            for (int xs = 1; xs < 8; ++xs) sum += *(const GAS f32x4*)(PART + ((size_t)xs * M + t) * 128 + k4);
            const float rstd = pg8::row_rstd(SSP, (int)t);
            const v2u ids = *(const GAS v2u*)(SELE + t * 128 + k4); const f32x4 gt = *(const GAS f32x4*)(SELG + t * 128 + k4);
            const unsigned e[4] = {ids.x & 0xffffu, ids.x >> 16, ids.y & 0xffffu, ids.y >> 16};
            f32x4 w;
#pragma unroll
            for (int c = 0; c < 4; ++c) { const f32x2 sc = *(const GAS f32x2*)(SCL + 2 * e[c]); w[c] = gt[c] * gelu_tanh(sum[c] * (rstd * sc[0])) * sc[1]; }
            *(GAS f32x4*)(PW + t * 128 + k4) = w;
        }
        if (BOTH(9)) GRID_BAR();
    }
    if (IN(10)) {
        peer_slice_pass<1>(F, V6S, SELE, PW, H2G, nullptr, g2, OUT);
    }
#undef IN
#undef BOTH
}

extern "C" void kernel_launch(void* const* d_in, const int* in_sizes, int n_in, void* d_out, int out_size, void* d_ws, size_t ws_size, hipStream_t stream) {
    static int grid = 0;
    if (grid == 0) {
        if (n_in != 22 || in_sizes[0] != M * DM || out_size != M * DM || ws_size < WS_END) { fprintf(stderr, "kernel_launch: unexpected shapes (n_in %d, in0 %d, out %d, ws %zu); nothing launched\n", n_in, n_in > 0 ? in_sizes[0] : -1, out_size, ws_size); grid = -1; return; }
        int dev = 0, cus = 0, per_cu = 0;
        if (hipGetDevice(&dev) != hipSuccess || hipDeviceGetAttribute(&cus, hipDeviceAttributeMultiprocessorCount, dev) != hipSuccess) { grid = -1; return; }
        if (hipFuncSetAttribute((const void*)mk_fwd, hipFuncAttributeMaxDynamicSharedMemorySize, LDS_BYTES) != hipSuccess) { fprintf(stderr, "kernel_launch: hipFuncSetAttribute failed\n"); grid = -1; return; }
        if (hipOccupancyMaxActiveBlocksPerMultiprocessor(&per_cu, (const void*)mk_fwd, NWAVES * 64, LDS_BYTES) != hipSuccess || per_cu < 1)
            fprintf(stderr, "kernel_launch: note: occupancy query reports %d workgroups per CU\n", per_cu);
        (void)hipGetLastError();
        grid = cus;
    }
    if (grid < 0) return;
    if (hipMemsetAsync((char*)d_ws + WS_CTL, 0, CTL_ZERO_BYTES, stream) != hipSuccess) return;
    Args a{};
    for (int i = 0; i < 22; ++i) a.in[i] = (const float*)d_in[i];
    a.out = (float*)d_out; a.ws = (unsigned char*)d_ws;
    if (N_LAUNCHES == 1) { a.ph_lo = 0; a.ph_hi = N_PHASES; a.li = 0; hipLaunchKernelGGL(mk_fwd, dim3(grid), dim3(NWAVES * 64), LDS_BYTES, stream, a); }
    else for (int li = 0; li < N_PHASES; ++li) { a.ph_lo = li; a.ph_hi = li + 1; a.li = li; hipLaunchKernelGGL(mk_fwd, dim3(grid), dim3(NWAVES * 64), LDS_BYTES, stream, a); }
}
```

```cpp
#include <hip/hip_runtime.h>
#include <cstdio>
#include <cstdint>

constexpr int BATCH = 2, SEQ = 8192, DM = 2048, M = BATCH * SEQ, NMETA = 16;
constexpr int INCOLS = 10240;
constexpr float EPS = 1e-6f;
constexpr float QSCALE = 0.125f * 1.4426950408889634f;
constexpr float LOG2E = 1.4426950408889634f;
constexpr float NEGBIG = -1.0e30f;

namespace pg8 {
#define PG8_LAS __attribute__((address_space(3)))
typedef unsigned short bf16_t;
typedef short bf16x8 __attribute__((ext_vector_type(8)));
typedef float f32x4 __attribute__((ext_vector_type(4)));
typedef unsigned u32x4 __attribute__((ext_vector_type(4)));
constexpr int BM = 256, BK = 64, HALF = 128, HTB = HALF * BK * 2  , STAGE_BYTES = 8 * HTB, NXCD = 8, WGM = 8;

__host__ __device__ __forceinline__ int lds_byte(int r, int c) { const int st = (r >> 4) * 2 + (c >> 5), rr = r & 15, cc = c & 31, ob = rr * 64 + cc * 2; return st * 1024 + (ob ^ (((ob >> 9) & 1) << 5)); }
__host__ __device__ __forceinline__ void stage_rc(int b, int& R, int& C) { const int st = b / 1024, sb = b % 1024, swz = sb ^ (((sb >> 9) & 1) << 5); R = (st >> 1) * 16 + swz / 64; C = (st & 1) * 32 + (swz % 64) / 2; }
__host__ __device__ __forceinline__ int perm32(int rho) { const int n = rho >> 4, i = rho & 15; return 8 * (i >> 2) + 4 * n + (i & 3); }

struct Unit { int pm, pn; };
struct Gemm { const bf16_t* A; const bf16_t* Bt; int M, N, K; };

struct StaticOrder {
    int nM, nN, nwg, G, c;
    __host__ __device__ void init(int M, int N, int G_, int c_) { nM = M / BM; nN = N / BM; nwg = nM * nN; G = G_; c = c_; }
    __host__ __device__ bool next(int i, Unit& u) const {
        const long L = (long)i * G + c; if (L >= nwg) return false;
        int wgid = (int)L; { const int q = nwg / NXCD, r = nwg % NXCD, xcd = wgid % NXCD, off = wgid / NXCD; wgid = (xcd < r ? xcd * (q + 1) : r * (q + 1) + (xcd - r) * q) + off; }
        const int nig = WGM * nN, gid = wgid / nig, fm = gid * WGM, gsz = (nM - fm) < WGM ? (nM - fm) : WGM;
        u.pm = fm + ((wgid % nig) % gsz); u.pn = (wgid % nig) / gsz; return true;
    }
    __device__ __forceinline__ void a_ready(const Unit&) const {}
    __device__ __forceinline__ void done(const Unit&) const {}
};


typedef float cvf32x2_t __attribute__((ext_vector_type(2))); typedef __bf16 cvbf16x2_t __attribute__((ext_vector_type(2)));
__device__ __forceinline__ unsigned cvt_pk_bf16(float lo, float hi) { const cvf32x2_t v = {lo, hi}; const cvbf16x2_t b = __builtin_convertvector(v, cvbf16x2_t); return __builtin_bit_cast(unsigned, b); }
__device__ __forceinline__ float bf_lo(unsigned w) { return __builtin_bit_cast(float, w << 16); }
__device__ __forceinline__ float bf_hi(unsigned w) { return __builtin_bit_cast(float, w & 0xffff0000u); }
__device__ __forceinline__ float sigmoidf_(float v) { return __builtin_amdgcn_rcpf(1.0f + __builtin_amdgcn_exp2f(-v * 1.4426950408889634f)); }

struct EpiIn {
    static constexpr bool PERM = true, AFTER_DRAIN = false;
    bf16_t *QDA, *KDA, *VDA, *QNA, *KNA, *VNA, *SGDA, *SGNA;
    const float *gq_da, *gk_da, *gq_na, *gk_na;
    __device__ __forceinline__ void operator()(const f32x4 (&acc)[2][2][4][2], const Unit& u, int wr, int wc, int fr, int fq) const {
        const int pn = u.pn; const int row0 = u.pm * BM + wr * 64 + fr;
        int kind, ct; bf16_t* base; const float* gain = nullptr; float osc = 1.f;
        if (pn < 4)       { kind = 1; base = QDA; ct = pn;      gain = gq_da; osc = QSCALE; }
        else if (pn < 8)  { kind = 1; base = KDA; ct = pn - 4;  gain = gk_da; }
        else if (pn < 12) { kind = 0; base = VDA; ct = pn - 8; }
        else if (pn < 16) { kind = 1; base = QNA; ct = pn - 12; gain = gq_na; osc = QSCALE; }
        else if (pn < 20) { kind = 1; base = KNA; ct = pn - 16; gain = gk_na; }
        else if (pn < 24) { kind = 0; base = VNA; ct = pn - 20; }
        else if (pn < 32) { kind = 2; base = SGDA; ct = pn - 24; }
        else              { kind = 2; base = SGNA; ct = pn - 32; }
        if (kind == 1) {
            f32x4 gv[2][2];
#pragma unroll
            for (int bj = 0; bj < 2; ++bj)
#pragma unroll
                for (int n = 0; n < 2; ++n) gv[bj][n] = *(const f32x4*)(gain + 32 * bj + 8 * fq + 4 * n);
#pragma unroll
            for (int ai = 0; ai < 2; ++ai)
#pragma unroll
                for (int m = 0; m < 4; ++m) {
                    float ss = 0.f;
#pragma unroll
                    for (int bj = 0; bj < 2; ++bj)
#pragma unroll
                        for (int n = 0; n < 2; ++n) { const f32x4 x = acc[ai][bj][m][n]; ss += (x[0] * x[0] + x[1] * x[1]) + (x[2] * x[2] + x[3] * x[3]); }
                    ss += __shfl_xor(ss, 16); ss += __shfl_xor(ss, 32);
                    const float rs = __builtin_amdgcn_rsqf(ss * (1.0f / 64.0f) + EPS) * osc;
                    bf16_t* rowp = base + (size_t)(row0 + ai * HALF + m * 16) * 1024 + ct * 256 + 64 * wc + 8 * fq;
#pragma unroll
                    for (int bj = 0; bj < 2; ++bj) { const f32x4 v0 = acc[ai][bj][m][0] * rs * gv[bj][0], v1 = acc[ai][bj][m][1] * rs * gv[bj][1];
                        u32x4 w; w.x = cvt_pk_bf16(v0[0], v0[1]); w.y = cvt_pk_bf16(v0[2], v0[3]); w.z = cvt_pk_bf16(v1[0], v1[1]); w.w = cvt_pk_bf16(v1[2], v1[3]);
                        *(u32x4*)(rowp + 32 * bj) = w; }
                }
        } else {
            const int ldc = (kind == 2) ? 2048 : 1024;
#pragma unroll
            for (int ai = 0; ai < 2; ++ai)
#pragma unroll
                for (int m = 0; m < 4; ++m) {
                    bf16_t* rowp = base + (size_t)(row0 + ai * HALF + m * 16) * ldc + ct * 256 + 32 * wc + 8 * fq;
#pragma unroll
                    for (int bj = 0; bj < 2; ++bj) { f32x4 v0 = acc[ai][bj][m][0], v1 = acc[ai][bj][m][1];
                        if (kind == 2) {
#pragma unroll
                            for (int j = 0; j < 4; ++j) { v0[j] = sigmoidf_(v0[j]); v1[j] = sigmoidf_(v1[j]); } }
                        u32x4 w; w.x = cvt_pk_bf16(v0[0], v0[1]); w.y = cvt_pk_bf16(v0[2], v0[3]); w.z = cvt_pk_bf16(v1[0], v1[1]); w.w = cvt_pk_bf16(v1[2], v1[3]);
                        *(u32x4*)(rowp + bj * HALF) = w; }
                }
        }
    }
};

template <int MODE> struct EpiGate {
    static constexpr bool PERM = true, AFTER_DRAIN = false;
    const bf16_t* G; const bf16_t* P; bf16_t* Y;
    __device__ __forceinline__ void operator()(const f32x4 (&acc)[2][2][4][2], const Unit& u, int wr, int wc, int fr, int fq) const {
        const int row0 = u.pm * BM + wr * 64 + fr, col0 = u.pn * BM + wc * 32 + 8 * fq;
#pragma unroll
        for (int ai = 0; ai < 2; ++ai)
#pragma unroll
            for (int m = 0; m < 4; ++m) { const size_t off = (size_t)(row0 + ai * HALF + m * 16) * 2048 + col0;
#pragma unroll
                for (int bj = 0; bj < 2; ++bj) { const u32x4 g = *(const u32x4*)(G + off + bj * HALF); const f32x4 a0 = acc[ai][bj][m][0], a1 = acc[ai][bj][m][1];
                    float r[8] = { bf_lo(g.x) * a0[0], bf_hi(g.x) * a0[1], bf_lo(g.y) * a0[2], bf_hi(g.y) * a0[3], bf_lo(g.z) * a1[0], bf_hi(g.z) * a1[1], bf_lo(g.w) * a1[2], bf_hi(g.w) * a1[3] };
                    if (MODE == 1) { const u32x4 p = *(const u32x4*)(P + off + bj * HALF);
                        r[0] += bf_lo(p.x); r[1] += bf_hi(p.x); r[2] += bf_lo(p.y); r[3] += bf_hi(p.y); r[4] += bf_lo(p.z); r[5] += bf_hi(p.z); r[6] += bf_lo(p.w); r[7] += bf_hi(p.w); }
                    u32x4 w; w.x = cvt_pk_bf16(r[0], r[1]); w.y = cvt_pk_bf16(r[2], r[3]); w.z = cvt_pk_bf16(r[4], r[5]); w.w = cvt_pk_bf16(r[6], r[7]);
                    *(u32x4*)(Y + off + bj * HALF) = w; } }
    }
};

struct EpiOut {
    static constexpr bool PERM = false, AFTER_DRAIN = false;
    const float* X; float* OUT; bf16_t* H2G; const float* g2; float* SSP;
    __device__ __forceinline__ void operator()(const f32x4 (&acc)[2][2][4][2], const Unit& u, int wr, int wc, int fr, int fq) const {
        const int row0 = u.pm * BM + wr * 64 + fr, col0 = u.pn * BM + wc * 32 + 4 * fq;
        f32x4 gv[2][2];
#pragma unroll
        for (int bj = 0; bj < 2; ++bj)
#pragma unroll
            for (int n = 0; n < 2; ++n) gv[bj][n] = *(const f32x4*)(g2 + col0 + bj * HALF + n * 16);
#pragma unroll
        for (int ai = 0; ai < 2; ++ai)
#pragma unroll
            for (int m = 0; m < 4; ++m) { const int row = row0 + ai * HALF + m * 16; const size_t off = (size_t)row * 2048 + col0; float ss = 0.f;
#pragma unroll
                for (int bj = 0; bj < 2; ++bj)
#pragma unroll
                    for (int n = 0; n < 2; ++n) { const f32x4 h = *(const f32x4*)(X + off + bj * HALF + n * 16) + acc[ai][bj][m][n];
                        ss += (h[0] * h[0] + h[1] * h[1]) + (h[2] * h[2] + h[3] * h[3]);
                        const f32x4 hg = h * gv[bj][n]; unsigned long long w = (unsigned long long)cvt_pk_bf16(hg[0], hg[1]) | ((unsigned long long)cvt_pk_bf16(hg[2], hg[3]) << 32);
                        *(unsigned long long*)(H2G + off + bj * HALF + n * 16) = w; }
                ss += __shfl_xor(ss, 16); ss += __shfl_xor(ss, 32);
                if (fq == 0) SSP[(size_t)row * 32 + u.pn * 4 + wc] = ss; }
    }
};

__device__ __forceinline__ float row_rstd(const float* SSP, int row) {
    const f32x4* p = (const f32x4*)(SSP + (size_t)row * 32); float s = 0.f;
#pragma unroll
    for (int i = 0; i < 8; ++i) { const f32x4 v = p[i]; s += (v[0] + v[1]) + (v[2] + v[3]); }
    return __builtin_amdgcn_rsqf(s * (1.0f / 2048.0f) + EPS);
}
struct EpiPQ {
    static constexpr bool PERM = true, AFTER_DRAIN = false;
    bf16_t* PQ; const float* SSP;
    __device__ __forceinline__ void operator()(const f32x4 (&acc)[2][2][4][2], const Unit& u, int wr, int wc, int fr, int fq) const {
        const int row0 = u.pm * BM + wr * 64 + fr, col0 = u.pn * BM + wc * 32 + 8 * fq;
#pragma unroll
        for (int ai = 0; ai < 2; ++ai)
#pragma unroll
            for (int m = 0; m < 4; ++m) { const int row = row0 + ai * HALF + m * 16; const float rs = row_rstd(SSP, row);
                bf16_t* rowp = PQ + (size_t)row * 2048 + col0;
#pragma unroll
                for (int bj = 0; bj < 2; ++bj) { const f32x4 v0 = acc[ai][bj][m][0] * rs, v1 = acc[ai][bj][m][1] * rs;
                    u32x4 w; w.x = cvt_pk_bf16(v0[0], v0[1]); w.y = cvt_pk_bf16(v0[2], v0[3]); w.z = cvt_pk_bf16(v1[0], v1[1]); w.w = cvt_pk_bf16(v1[2], v1[3]);
                    *(u32x4*)(rowp + bj * HALF) = w; } }
    }
};

template <class Epi, class Sched, bool ALIGN_EPI = false, bool SP2 = false>
__device__ __forceinline__ void gemm_phase(PG8_LAS unsigned char* lds, const Gemm g, const Sched& S, const Epi& E) {
    const int tid = threadIdx.x, wid = __builtin_amdgcn_readfirstlane(tid >> 6), lane = tid & 63, wr = wid >> 2, wc = wid & 3, fr = lane & 15, fq = lane >> 4;
    const int K = g.K, nt = K / BK;
    unsigned voffA[2], voffB[2];
#pragma unroll
    for (int i = 0; i < 2; ++i) { int R, C; stage_rc(tid * 16 + i * 8192, R, C); const int Rb = Epi::PERM ? ((R & ~31) + perm32(R & 31)) : R;
        voffA[i] = (unsigned)(R * K + C) * 2u; voffB[i] = (unsigned)(Rb * K + C) * 2u; }
    const size_t kstep = (size_t)(BK * 2);
    const size_t hstep = (size_t)HALF * K * 2;
    const size_t tstep = 2 * hstep;
    const unsigned ldsw = (unsigned)wid * 1024u;
    const int aoff = lds_byte(wr * 64 + fr, fq * 8), boff = lds_byte(wc * 32 + fr, fq * 8);
#define PG8_SA(b, h) (((b) * 2 + (h)) * HTB)
#define PG8_SB(b, h) ((4 + (b) * 2 + (h)) * HTB)
#define PG8_STAGE(bufoff, gbase, voff) do { _Pragma("unroll") for (int _i = 0; _i < 2; ++_i) \
        __builtin_amdgcn_global_load_lds((const unsigned*)((const char*)(gbase) + (voff)[_i]), (PG8_LAS unsigned*)(lds + (bufoff) + ldsw + _i * 8192), 16, 0, 0); } while (0)
#define PG8_LDA(dst, b, h) do { _Pragma("unroll") for (int m = 0; m < 4; ++m) _Pragma("unroll") for (int k = 0; k < 2; ++k) dst[m][k] = *(const PG8_LAS bf16x8*)(lds + PG8_SA(b, h) + aoff + m * 2048 + k * 1024); } while (0)
#define PG8_LDB(dst, b, h) do { _Pragma("unroll") for (int n = 0; n < 2; ++n) _Pragma("unroll") for (int k = 0; k < 2; ++k) dst[n][k] = *(const PG8_LAS bf16x8*)(lds + PG8_SB(b, h) + boff + n * 2048 + k * 1024); } while (0)
#define PG8_MMA(ai, bj, At, Bt) do { __builtin_amdgcn_s_setprio(1); _Pragma("unroll") for (int m = 0; m < 4; ++m) _Pragma("unroll") for (int n = 0; n < 2; ++n) _Pragma("unroll") for (int k = 0; k < 2; ++k) \
        acc[ai][bj][m][n] = __builtin_amdgcn_mfma_f32_16x16x32_bf16(Bt[n][k], At[m][k], acc[ai][bj][m][n], 0, 0, 0); __builtin_amdgcn_s_setprio(0); } while (0)
#define PG8_WAIT_V(n) asm volatile("s_waitcnt vmcnt(" #n ")" ::: "memory")
#define PG8_WAIT_L(n) asm volatile("s_waitcnt lgkmcnt(" #n ")" ::: "memory")
#define PG8_BAR __builtin_amdgcn_s_barrier()
#define PG8_SCHED __builtin_amdgcn_sched_barrier(0)
    Unit cur, nxt; int ui = 0;
    if (!S.next(0, cur)) return;
    f32x4 acc[2][2][4][2];
#pragma unroll
    for (int a = 0; a < 2; ++a)
#pragma unroll
        for (int b = 0; b < 2; ++b)
#pragma unroll
            for (int m = 0; m < 4; ++m)
#pragma unroll
                for (int n = 0; n < 2; ++n) acc[a][b][m][n] = (f32x4){0.f, 0.f, 0.f, 0.f};
    bf16x8 At[4][2], B0[2][2], B1[2][2];
    const char* cA = (const char*)g.A + (size_t)cur.pm * tstep; const char* cB = (const char*)g.Bt + (size_t)cur.pn * tstep;
    S.a_ready(cur);
    if constexpr (SP2) {
        PG8_STAGE(PG8_SB(0, 0), cB, voffB); PG8_STAGE(PG8_SB(0, 1), cB + hstep, voffB); PG8_STAGE(PG8_SA(0, 0), cA, voffA); PG8_STAGE(PG8_SA(0, 1), cA + hstep, voffA);
        if (wr == 1) PG8_BAR;
        PG8_WAIT_V(2); PG8_BAR;
        PG8_STAGE(PG8_SB(1, 0), cB + kstep, voffB); PG8_STAGE(PG8_SA(1, 0), cA + kstep, voffA); PG8_STAGE(PG8_SB(1, 1), cB + hstep + kstep, voffB);
        PG8_WAIT_V(6); PG8_BAR;
    } else {
        PG8_STAGE(PG8_SB(0, 0), cB, voffB); PG8_STAGE(PG8_SA(0, 0), cA, voffA); PG8_STAGE(PG8_SB(0, 1), cB + hstep, voffB); PG8_STAGE(PG8_SA(0, 1), cA + hstep, voffA);
        if (wr == 1) PG8_BAR;
        PG8_WAIT_V(4); PG8_BAR;
        PG8_STAGE(PG8_SB(1, 0), cB + kstep, voffB); PG8_STAGE(PG8_SA(1, 0), cA + kstep, voffA); PG8_STAGE(PG8_SB(1, 1), cB + hstep + kstep, voffB);
        PG8_WAIT_V(6); PG8_BAR;
    }
    for (;;) {
        const bool has_next = S.next(ui + 1, nxt);
        const char* nA = has_next ? (const char*)g.A + (size_t)nxt.pm * tstep : cA; const char* nB = has_next ? (const char*)g.Bt + (size_t)nxt.pn * tstep : cB;
        for (int t = 0; t < nt; t += 2) {
            const bool last = (t == nt - 2);
            const char* a1 = cA + (size_t)(t + 1) * kstep;
            const char* a2 = last ? nA : cA + (size_t)(t + 2) * kstep; const char* b2 = last ? nB : cB + (size_t)(t + 2) * kstep;
            const char* a3 = a2 + kstep; const char* b3 = b2 + kstep;
            if (last && has_next) S.a_ready(nxt);
            if constexpr (SP2) {
            PG8_LDB(B0, 0, 0); PG8_LDB(B1, 0, 1); PG8_SCHED; PG8_LDA(At, 0, 0); PG8_STAGE(PG8_SA(1, 1), a1 + hstep, voffA);
            PG8_WAIT_V(8); PG8_WAIT_L(0); PG8_BAR; PG8_MMA(0, 0, At, B0); PG8_MMA(0, 1, At, B1); PG8_BAR; PG8_SCHED;
            PG8_LDA(At, 0, 1); PG8_STAGE(PG8_SB(0, 0), b2, voffB); PG8_STAGE(PG8_SB(0, 1), b2 + hstep, voffB); PG8_STAGE(PG8_SA(0, 0), a2, voffA);
            PG8_WAIT_V(8); PG8_WAIT_L(0); PG8_BAR; PG8_MMA(1, 0, At, B0); PG8_MMA(1, 1, At, B1); PG8_BAR; PG8_SCHED;
            PG8_LDB(B0, 1, 0); PG8_LDB(B1, 1, 1); PG8_SCHED; PG8_LDA(At, 1, 0); PG8_STAGE(PG8_SA(0, 1), a2 + hstep, voffA);
            PG8_WAIT_V(8); PG8_WAIT_L(0); PG8_BAR; PG8_MMA(0, 0, At, B0); PG8_MMA(0, 1, At, B1); PG8_BAR; PG8_SCHED;
            PG8_LDA(At, 1, 1); PG8_STAGE(PG8_SB(1, 0), b3, voffB); PG8_STAGE(PG8_SB(1, 1), b3 + hstep, voffB); PG8_STAGE(PG8_SA(1, 0), a3, voffA);
            PG8_WAIT_V(8); PG8_WAIT_L(0); PG8_BAR; PG8_MMA(1, 0, At, B0); PG8_MMA(1, 1, At, B1); PG8_BAR; PG8_SCHED;
            } else {
            PG8_LDB(B0, 0, 0); PG8_SCHED; PG8_LDA(At, 0, 0); PG8_STAGE(PG8_SA(1, 1), a1 + hstep, voffA);
            PG8_WAIT_L(8); PG8_BAR; PG8_WAIT_L(0); PG8_MMA(0, 0, At, B0); PG8_BAR; PG8_SCHED;
            PG8_LDB(B1, 0, 1); PG8_STAGE(PG8_SB(0, 0), b2, voffB);
            PG8_BAR; PG8_WAIT_L(0); PG8_MMA(0, 1, At, B1); PG8_BAR;
            PG8_LDA(At, 0, 1); PG8_STAGE(PG8_SA(0, 0), a2, voffA);
            PG8_BAR; PG8_WAIT_L(0); PG8_MMA(1, 0, At, B0); PG8_BAR; PG8_SCHED;
            PG8_STAGE(PG8_SB(0, 1), b2 + hstep, voffB);
            PG8_WAIT_V(6); PG8_BAR; PG8_MMA(1, 1, At, B1); PG8_BAR;
            PG8_LDB(B0, 1, 0); PG8_SCHED; PG8_LDA(At, 1, 0); PG8_STAGE(PG8_SA(0, 1), a2 + hstep, voffA);
            PG8_WAIT_L(8); PG8_BAR; PG8_WAIT_L(0); PG8_MMA(0, 0, At, B0); PG8_BAR; PG8_SCHED;
            PG8_LDB(B1, 1, 1); PG8_STAGE(PG8_SB(1, 0), b3, voffB);
            PG8_BAR; PG8_WAIT_L(0); PG8_MMA(0, 1, At, B1); PG8_BAR;
            PG8_LDA(At, 1, 1); PG8_STAGE(PG8_SA(1, 0), a3, voffA);
            PG8_BAR; PG8_WAIT_L(0); PG8_MMA(1, 0, At, B0); PG8_BAR; PG8_SCHED;
            PG8_STAGE(PG8_SB(1, 1), b3 + hstep, voffB);
            PG8_WAIT_V(6); PG8_BAR; PG8_MMA(1, 1, At, B1); PG8_BAR;
            }
        }
        if constexpr (ALIGN_EPI) { if (wr == 0) PG8_BAR; }
        if constexpr (!Epi::AFTER_DRAIN) { E(acc, cur, wr, wc, fr, fq); S.done(cur); }
        if (!has_next) break;
#pragma unroll
        for (int a = 0; a < 2; ++a)
#pragma unroll
            for (int b = 0; b < 2; ++b)
#pragma unroll
                for (int m = 0; m < 4; ++m)
#pragma unroll
                    for (int n = 0; n < 2; ++n) acc[a][b][m][n] = (f32x4){0.f, 0.f, 0.f, 0.f};
        cur = nxt; cA = nA; cB = nB; ++ui;
        if constexpr (ALIGN_EPI) { if (wr == 1) PG8_BAR; }
    }
    PG8_WAIT_V(0);
    if constexpr (!ALIGN_EPI) { if (wr == 0) PG8_BAR; }
    PG8_BAR;
    if constexpr (Epi::AFTER_DRAIN) { E.fused(acc, cur, wr, wc, fr, fq, lds, wid, lane); S.done(cur); }
#undef PG8_SA
#undef PG8_SB
#undef PG8_STAGE
#undef PG8_LDA
#undef PG8_LDB
#undef PG8_MMA
#undef PG8_WAIT_V
#undef PG8_WAIT_L
#undef PG8_BAR
#undef PG8_SCHED
}
}

namespace att {
#define ATT_LAS __attribute__((address_space(3)))
typedef unsigned short bf16_t;
typedef short bf16x8 __attribute__((ext_vector_type(8)));
typedef short s16x4 __attribute__((ext_vector_type(4)));
typedef float f32x16 __attribute__((ext_vector_type(16)));
typedef float f32x4 __attribute__((ext_vector_type(4)));
typedef unsigned u32x4 __attribute__((ext_vector_type(4)));
typedef unsigned u32x2 __attribute__((ext_vector_type(2)));
typedef ATT_LAS const char* lds_cptr;
constexpr int NSLOT = 4, KSLOT = 8192, VSLOT = 16384;
constexpr int LDS_K = 0, LDS_V = NSLOT * KSLOT, LDS_TBL = LDS_V + NSLOT * VSLOT, TBL_FLOATS = 640, LDS_BYTES = LDS_TBL + TBL_FLOATS * 4;

__device__ __forceinline__ void glds16(const void* gsrc, unsigned lds_dst) { unsigned keep;
    asm volatile("s_mov_b32 %0, m0\n\ts_mov_b32 m0, %2\n\ts_nop 0\n\tglobal_load_lds_dwordx4 %1, off\n\ts_mov_b32 m0, %0" : "=&s"(keep) : "v"(gsrc), "s"(lds_dst) : "memory"); }
#define ATT_WAIT_BAR(N) asm volatile("s_waitcnt vmcnt(" #N ") lgkmcnt(0)\n\ts_barrier" ::: "memory")
__device__ __forceinline__ unsigned cvtpk(float lo, float hi) { return pg8::cvt_pk_bf16(lo, hi); }
typedef short v4i16_t __attribute__((ext_vector_type(4)));
__device__ __forceinline__ s16x4 vtr(lds_cptr p) { return __builtin_bit_cast(s16x4, __builtin_amdgcn_ds_read_tr16_b64_v4i16((ATT_LAS v4i16_t*)p)); }
__device__ __forceinline__ int crow(int r, int hi) { return (r & 3) + 8 * (r >> 2) + 4 * hi; }

template <int KIND>
__device__ __forceinline__ void na_tile(lds_cptr Ks, lds_cptr Vl, const bf16x8 (&qr)[4], f32x16 (&oT)[2], float& mref, float& lsum, const f32x16& ma0, const f32x16& ma1, const ATT_LAS float* tb, int r32, int hi) {
#define NA_V0(r) (KIND == 0 || (KIND == 1 && (r) >= 12))
#define NA_V1(r) ((KIND == 0 && (r) < 4) || KIND == 1 || (KIND == 2 && (r) >= 8))
    f32x16 p0, p1;
#pragma unroll
    for (int r = 0; r < 16; ++r) { p0[r] = (KIND == 2) ? 0.f : ma0[r] - mref; p1[r] = (KIND == 2) ? -mref : ma1[r] - mref; }
    const lds_cptr kb = Ks + hi * 1024 + r32 * 16;
#pragma unroll
    for (int d0 = 0; d0 < 4; ++d0) {
        if (KIND != 2) { const bf16x8 b0 = *(const ATT_LAS bf16x8*)(kb + d0 * 2048); p0 = __builtin_amdgcn_mfma_f32_32x32x16_bf16(b0, qr[d0], p0, 0, 0, 0); }
        { const bf16x8 b1 = *(const ATT_LAS bf16x8*)(kb + d0 * 2048 + 512); p1 = __builtin_amdgcn_mfma_f32_32x32x16_bf16(b1, qr[d0], p1, 0, 0, 0); }
    }
    if (KIND != 2) {
#pragma unroll
        for (int r = 0; r < 16; ++r) { const int cr = (r & 3) + 8 * (r >> 2); if (NA_V0(r)) p0[r] += tb[cr]; if (NA_V1(r)) p1[r] += tb[cr + 32]; }
    }
    float tm = -3.0e38f;
#pragma unroll
    for (int r = 0; r < 16; ++r) { if (NA_V0(r)) tm = __builtin_fmaxf(tm, p0[r]); if (NA_V1(r)) tm = __builtin_fmaxf(tm, p1[r]); }
    { const auto rr = __builtin_amdgcn_permlane32_swap(__builtin_bit_cast(unsigned, tm), __builtin_bit_cast(unsigned, tm), false, false);
      tm = __builtin_fmaxf(__builtin_bit_cast(float, rr[0]), __builtin_bit_cast(float, rr[1])); }
    if (__any(tm > 8.0f)) {
        const float d = __builtin_fmaxf(tm, 0.f), alpha = __builtin_amdgcn_exp2f(-d);
        mref += d; lsum *= alpha;
#pragma unroll
        for (int r = 0; r < 16; ++r) { p0[r] -= d; p1[r] -= d; }
#pragma unroll
        for (int db = 0; db < 2; ++db)
#pragma unroll
            for (int r = 0; r < 16; ++r) oT[db][r] *= alpha;
    }
    float s0 = 0.f, s1 = 0.f;
#pragma unroll
    for (int r = 0; r < 16; ++r) {
        if (NA_V0(r)) { p0[r] = __builtin_amdgcn_exp2f(p0[r]); s0 += p0[r]; } else p0[r] = 0.f;
        if (NA_V1(r)) { p1[r] = __builtin_amdgcn_exp2f(p1[r]); s1 += p1[r]; } else p1[r] = 0.f; }
    lsum += s0 + s1;
    bf16x8 pw[4];
    { u32x4 w;
      w.x = cvtpk(p0[0], p0[1]); w.y = cvtpk(p0[2], p0[3]); w.z = cvtpk(p0[4], p0[5]); w.w = cvtpk(p0[6], p0[7]); pw[0] = __builtin_bit_cast(bf16x8, w);
      w.x = cvtpk(p0[8], p0[9]); w.y = cvtpk(p0[10], p0[11]); w.z = cvtpk(p0[12], p0[13]); w.w = cvtpk(p0[14], p0[15]); pw[1] = __builtin_bit_cast(bf16x8, w);
      w.x = cvtpk(p1[0], p1[1]); w.y = cvtpk(p1[2], p1[3]); w.z = cvtpk(p1[4], p1[5]); w.w = cvtpk(p1[6], p1[7]); pw[2] = __builtin_bit_cast(bf16x8, w);
      w.x = cvtpk(p1[8], p1[9]); w.y = cvtpk(p1[10], p1[11]); w.z = cvtpk(p1[12], p1[13]); w.w = cvtpk(p1[14], p1[15]); pw[3] = __builtin_bit_cast(bf16x8, w); }
#pragma unroll
    for (int db = 0; db < 2; ++db)
#pragma unroll
        for (int ks = 0; ks < 4; ++ks) {
            const bool live = (ks == 0) ? NA_V0(0) : (ks == 1) ? NA_V0(15) : (ks == 2) ? NA_V1(0) : NA_V1(15);
            if (live) {
                const lds_cptr vp = Vl + db * 4096 + ks * 1024;
                const s16x4 lo = vtr(vp), h4 = vtr(vp + 512);
                const bf16x8 vf = (bf16x8){lo[0], lo[1], lo[2], lo[3], h4[0], h4[1], h4[2], h4[3]};
                oT[db] = __builtin_amdgcn_mfma_f32_32x32x16_bf16(vf, pw[ks], oT[db], 0, 0, 0);
            }
        }
#undef NA_V0
#undef NA_V1
}

__device__ __forceinline__ void store_block_w16(bf16_t* rowp, const f32x16& o, float sc, int hi) {
#pragma unroll
    for (int g = 0; g < 4; g += 2) {
        unsigned ax = cvtpk(o[4 * g] * sc, o[4 * g + 1] * sc), ay = cvtpk(o[4 * g + 2] * sc, o[4 * g + 3] * sc);
        unsigned bx = cvtpk(o[4 * g + 4] * sc, o[4 * g + 5] * sc), by = cvtpk(o[4 * g + 6] * sc, o[4 * g + 7] * sc);
        { const auto r = __builtin_amdgcn_permlane32_swap(ax, bx, false, false); ax = r[0]; bx = r[1]; }
        { const auto r = __builtin_amdgcn_permlane32_swap(ay, by, false, false); ay = r[0]; by = r[1]; }
        *(u32x4*)(rowp + 8 * (g + hi)) = (u32x4){ax, ay, bx, by};
    }
}

struct DAParams { const bf16_t *Q, *K, *V, *Kmeta, *Vmeta; bf16_t* OC; float mref; };

template <bool GEN, bool META, bool DO_PV>
__device__ __forceinline__ void da_step(lds_cptr Ks, lds_cptr Vp, const bf16x8 (&qr)[4], bf16x8 qx, bf16x8 kx0, bf16x8 kx1, f32x16 (&oT)[4], float& lsum, bf16x8 (&pw)[4],
                                        float qrel4, float sl2, float mref, int r32, int hi) {
#define SBAR() __builtin_amdgcn_sched_barrier(0)
#define DA_VFRAG(dst, i) do { const lds_cptr vp_ = Vp + ((i) >> 2) * 4096 + ((i) & 3) * 1024; const s16x4 lo_ = vtr(vp_), h4_ = vtr(vp_ + 512); \
        dst = (bf16x8){lo_[0], lo_[1], lo_[2], lo_[3], h4_[0], h4_[1], h4_[2], h4_[3]}; } while (0)
    constexpr int PF = 5, NR = 6;
    bf16x8 vf[NR];
    if (DO_PV) {
#pragma unroll
        for (int i = 0; i < PF; ++i) DA_VFRAG(vf[i], i);
    }
    f32x16 p0, p1;
    if (GEN) {
#pragma unroll
        for (int r = 0; r < 16; ++r) { p0[r] = -mref; p1[r] = -mref; }
    } else {
        f32x16 z;
#pragma unroll
        for (int r = 0; r < 16; ++r) z[r] = 0.f;
        p0 = __builtin_amdgcn_mfma_f32_32x32x16_bf16(kx0, qx, z, 0, 0, 0);
        p1 = __builtin_amdgcn_mfma_f32_32x32x16_bf16(kx1, qx, z, 0, 0, 0);
    }
    const lds_cptr kb = Ks + hi * 1024 + r32 * 16;
#pragma unroll
    for (int d0 = 0; d0 < 4; ++d0) {
        const bf16x8 b0 = *(const ATT_LAS bf16x8*)(kb + d0 * 2048), b1 = *(const ATT_LAS bf16x8*)(kb + d0 * 2048 + 512);
        p0 = __builtin_amdgcn_mfma_f32_32x32x16_bf16(b0, qr[d0], p0, 0, 0, 0);
        p1 = __builtin_amdgcn_mfma_f32_32x32x16_bf16(b1, qr[d0], p1, 0, 0, 0);
    }
    if (GEN) {
#pragma unroll
        for (int r = 0; r < 16; ++r) { const float c = (float)((r & 3) + 8 * (r >> 2));
            p0[r] = __builtin_fmaf(-sl2, __builtin_fabsf(qrel4 - c), p0[r]);
            p1[r] = __builtin_fmaf(-sl2, __builtin_fabsf(qrel4 - (c + 32.0f)), p1[r]); }
    }
    if (META) {
#pragma unroll
        for (int r = 0; r < 16; ++r) p0[r] = NEGBIG;
#pragma unroll
        for (int r = 0; r < 8; ++r) p1[r] = NEGBIG;
    }
    if (DO_PV) {
        float s0 = 0.f, s1 = 0.f;
        SBAR();
#pragma unroll
        for (int i = 0; i < 16; ++i) {
            if (i + PF < 16) DA_VFRAG(vf[(i + PF) % NR], i + PF);
            SBAR();
            oT[i >> 2] = __builtin_amdgcn_mfma_f32_32x32x16_bf16(vf[i % NR], pw[i & 3], oT[i >> 2], 0, 0, 0);
            SBAR();
            if (i < 8) { p0[2 * i] = __builtin_amdgcn_exp2f(p0[2 * i]); p0[2 * i + 1] = __builtin_amdgcn_exp2f(p0[2 * i + 1]); s0 += p0[2 * i]; s1 += p0[2 * i + 1]; }
            else { p1[2 * i - 16] = __builtin_amdgcn_exp2f(p1[2 * i - 16]); p1[2 * i - 15] = __builtin_amdgcn_exp2f(p1[2 * i - 15]); s0 += p1[2 * i - 16]; s1 += p1[2 * i - 15]; }
            asm volatile("" : "+v"(s0), "+v"(s1));
            SBAR();
        }
        lsum += s0 + s1;
#pragma unroll
        for (int ks = 0; ks < 4; ++ks) {
            { u32x4 w;
              if (ks == 0) { w.x = cvtpk(p0[0], p0[1]); w.y = cvtpk(p0[2], p0[3]); w.z = cvtpk(p0[4], p0[5]); w.w = cvtpk(p0[6], p0[7]); }
              else if (ks == 1) { w.x = cvtpk(p0[8], p0[9]); w.y = cvtpk(p0[10], p0[11]); w.z = cvtpk(p0[12], p0[13]); w.w = cvtpk(p0[14], p0[15]); }
              else if (ks == 2) { w.x = cvtpk(p1[0], p1[1]); w.y = cvtpk(p1[2], p1[3]); w.z = cvtpk(p1[4], p1[5]); w.w = cvtpk(p1[6], p1[7]); }
              else { w.x = cvtpk(p1[8], p1[9]); w.y = cvtpk(p1[10], p1[11]); w.z = cvtpk(p1[12], p1[13]); w.w = cvtpk(p1[14], p1[15]); }
              pw[ks] = __builtin_bit_cast(bf16x8, w); }
        }
    } else {
        float s0 = 0.f, s1 = 0.f;
#pragma unroll
        for (int r = 0; r < 16; ++r) { p0[r] = __builtin_amdgcn_exp2f(p0[r]); p1[r] = __builtin_amdgcn_exp2f(p1[r]); s0 += p0[r]; s1 += p1[r]; }
        lsum += s0 + s1;
        u32x4 w;
        w.x = cvtpk(p0[0], p0[1]); w.y = cvtpk(p0[2], p0[3]); w.z = cvtpk(p0[4], p0[5]); w.w = cvtpk(p0[6], p0[7]); pw[0] = __builtin_bit_cast(bf16x8, w);
        w.x = cvtpk(p0[8], p0[9]); w.y = cvtpk(p0[10], p0[11]); w.z = cvtpk(p0[12], p0[13]); w.w = cvtpk(p0[14], p0[15]); pw[1] = __builtin_bit_cast(bf16x8, w);
        w.x = cvtpk(p1[0], p1[1]); w.y = cvtpk(p1[2], p1[3]); w.z = cvtpk(p1[4], p1[5]); w.w = cvtpk(p1[6], p1[7]); pw[2] = __builtin_bit_cast(bf16x8, w);
        w.x = cvtpk(p1[8], p1[9]); w.y = cvtpk(p1[10], p1[11]); w.z = cvtpk(p1[12], p1[13]); w.w = cvtpk(p1[14], p1[15]); pw[3] = __builtin_bit_cast(bf16x8, w);
    }
#undef DA_VFRAG
#undef SBAR
}

__device__ __forceinline__ void da_unit(ATT_LAS char* lds, unsigned lds0, const DAParams& P, int b, int h, int c, int qb, int Tlo, int Thi) {
    int tid = threadIdx.x; asm volatile("" : "+v"(tid));
    const int lane = tid & 63, r32 = lane & 31, hi = lane >> 5; const int wid = __builtin_amdgcn_readfirstlane(tid >> 6);
    const int qi0 = qb * 256 + wid * 32, qi = qi0 + r32;
    const size_t mrow = (size_t)b * SEQ + qi;
    const float slp2 = __builtin_amdgcn_exp2f(-(float)(h + 1)) * LOG2E, mref = P.mref;
    const lds_cptr ldsc = (lds_cptr)lds;
    const lds_cptr vl0 = ldsc + LDS_V + ((lane >> 4) & 1) * 32 + (lane & 3) * 8 + (4 * hi + ((lane & 15) >> 2)) * 64;
    const bf16_t* Qp = P.Q + mrow * 1024 + h * 128 + c * 64;
    bf16x8 qr[4];
#pragma unroll
    for (int d0 = 0; d0 < 4; ++d0) qr[d0] = *(const bf16x8*)(Qp + d0 * 16 + hi * 8);
    asm volatile("s_waitcnt vmcnt(0)" : "+v"(qr[0]), "+v"(qr[1]), "+v"(qr[2]), "+v"(qr[3]) :: "memory");
    const int kcol = h * 128 + c * 64, vcol = h * 128;
    const bf16_t* kreal = P.K + (size_t)b * SEQ * 1024 + kcol + (size_t)lane * 1024 + wid * 8;
    const bf16_t* kmeta = P.Kmeta + kcol + (size_t)lane * 1024 + wid * 8;
    const int vro = (16 * (wid & 3) + (lane >> 2)) * 1024 + (lane & 3) * 8;
    const bf16_t* vreal = P.V + (size_t)b * SEQ * 1024 + vcol + vro + 32 * (wid >> 2);
    const bf16_t* vmeta = P.Vmeta + vcol + vro + 32 * (wid >> 2);
#define DA_DMA(T, slot) do { const int T_ = (T); const unsigned so_ = (unsigned)(slot); \
    const bf16_t* ks_ = T_ == 0 ? kmeta : kreal + (size_t)(T_ - 1) * 65536; const bf16_t* vs_ = T_ == 0 ? vmeta : vreal + (size_t)(T_ - 1) * 65536; \
    glds16(ks_, (unsigned)__builtin_amdgcn_readfirstlane(lds0 + LDS_K + so_ * KSLOT + wid * 1024)); \
    glds16(vs_, (unsigned)__builtin_amdgcn_readfirstlane(lds0 + LDS_V + so_ * VSLOT + wid * 1024)); \
    glds16(vs_ + 64, (unsigned)__builtin_amdgcn_readfirstlane(lds0 + LDS_V + so_ * VSLOT + (wid + 8) * 1024)); } while (0)
#define DA_MODE(T) ((qi0 - 64 * ((T) - 1) - 4 >= 59) ? 0 : ((qi0 - 64 * ((T) - 1) + 31 <= 0) ? 1 : 2))
    bf16x8 kx0, kx1;
    { const unsigned m = hi ? 0u : 0xffffffffu;
      const u32x4 a0 = (u32x4){cvtpk((float)r32, (float)r32) & m, 0x3f803f80u & m, 0u, 0u}, a1 = (u32x4){cvtpk((float)(r32 + 32), (float)(r32 + 32)) & m, 0x3f803f80u & m, 0u, 0u};
      kx0 = __builtin_bit_cast(bf16x8, a0); kx1 = __builtin_bit_cast(bf16x8, a1); }
    const float sg_hi = __builtin_bit_cast(float, cvtpk(slp2, 0.f) << 16), sg_lo = slp2 - sg_hi;
#define DA_QX(dst, T, md) do { const float sg_ = ((md) == 0) ? 1.0f : -1.0f; const float lb_ = -sg_ * slp2 * (float)(qi - 64 * ((T) - 1)) - mref; \
        const float lbh_ = __builtin_bit_cast(float, cvtpk(lb_, 0.f) << 16); const unsigned m_ = hi ? 0u : 0xffffffffu; \
        const u32x4 q_ = (u32x4){cvtpk(sg_ * sg_hi, sg_ * sg_lo) & m_, cvtpk(lbh_, lb_ - lbh_) & m_, 0u, 0u}; dst = __builtin_bit_cast(bf16x8, q_); } while (0)
    f32x16 oT[4]; float lsum = 0.f;
#pragma unroll
    for (int r = 0; r < 16; ++r) { oT[0][r] = 0.f; oT[1][r] = 0.f; oT[2][r] = 0.f; oT[3][r] = 0.f; }
    bf16x8 pw[4];
    DA_DMA(Tlo, 0); DA_DMA(Tlo + 1, 1);
    ATT_WAIT_BAR(3);
    DA_DMA(Tlo + 2, 2);
    { const int md = DA_MODE(Tlo); bf16x8 qx; DA_QX(qx, Tlo, md); const float q4 = (float)(qi - 64 * (Tlo - 1) - 4 * hi);
      if (Tlo == 0) da_step<false, true, false>(ldsc + LDS_K, vl0, qr, qx, kx0, kx1, oT, lsum, pw, q4, slp2, mref, r32, hi);
      else if (md == 2) da_step<true, false, false>(ldsc + LDS_K, vl0, qr, qx, kx0, kx1, oT, lsum, pw, q4, slp2, mref, r32, hi);
      else da_step<false, false, false>(ldsc + LDS_K, vl0, qr, qx, kx0, kx1, oT, lsum, pw, q4, slp2, mref, r32, hi); }
    int sk = 1, sv = 0, sd = 3;
#pragma unroll 1
    for (int T = Tlo + 1; T <= Thi; ++T) {
        if (T + 1 <= Thi) ATT_WAIT_BAR(3); else ATT_WAIT_BAR(0);
        if (T + 2 <= Thi) DA_DMA(T + 2, sd);
        const int md = DA_MODE(T); bf16x8 qx; DA_QX(qx, T, md); const float q4 = (float)(qi - 64 * (T - 1) - 4 * hi);
        if (md == 2) da_step<true, false, true>(ldsc + LDS_K + sk * KSLOT, vl0 + sv * VSLOT, qr, qx, kx0, kx1, oT, lsum, pw, q4, slp2, mref, r32, hi);
        else da_step<false, false, true>(ldsc + LDS_K + sk * KSLOT, vl0 + sv * VSLOT, qr, qx, kx0, kx1, oT, lsum, pw, q4, slp2, mref, r32, hi);
        sk = (sk + 1) & 3; sv = (sv + 1) & 3; sd = (sd + 1) & 3;
    }
    {
        const lds_cptr Vp = vl0 + sv * VSLOT;
#pragma unroll
        for (int db = 0; db < 4; ++db)
#pragma unroll
            for (int ks = 0; ks < 4; ++ks) { const lds_cptr vp = Vp + db * 4096 + ks * 1024; const s16x4 lo = vtr(vp), h4 = vtr(vp + 512);
                const bf16x8 vf = (bf16x8){lo[0], lo[1], lo[2], lo[3], h4[0], h4[1], h4[2], h4[3]}; oT[db] = __builtin_amdgcn_mfma_f32_32x32x16_bf16(vf, pw[ks], oT[db], 0, 0, 0); }
    }
    ATT_WAIT_BAR(0);
#undef DA_DMA
#undef DA_QX
#undef DA_MODE
    const float inv = __builtin_amdgcn_rcpf(lsum + __shfl_xor(lsum, 32));
    bf16_t* Op = P.OC + (size_t)c * M * 1024 + mrow * 1024 + h * 128;
#pragma unroll
    for (int db = 0; db < 4; ++db) store_block_w16(Op + 32 * db, oT[db], inv, hi);
    asm volatile("s_waitcnt vmcnt(0)" ::: "memory");
}

struct NAParams { const bf16_t *Q, *K, *V, *Kmeta, *Vmeta; bf16_t* O; const float* rpb; };

__device__ __forceinline__ void na_unit(ATT_LAS char* lds, unsigned lds0, const NAParams& P, int b, int h, int rblk) {
    const int tid = threadIdx.x, lane = tid & 63, r32 = lane & 31, hi = lane >> 5; const int wid = __builtin_amdgcn_readfirstlane(tid >> 6);
    const lds_cptr ldsc = (lds_cptr)lds;
    ATT_LAS float* tbl = (ATT_LAS float*)(lds + LDS_TBL);
    { int tq = tid; asm volatile("" : "+v"(tq));
      if (tq < 465) tbl[64 + tq] = P.rpb[h * 465 + tq] * LOG2E; }
    const int rq = 4 * rblk + (wid >> 1), c = 32 * (wid & 1) + r32;
    int cs = c - 8; cs = cs < 0 ? 0 : (cs > 48 ? 48 : cs);
    int r0 = rq - 4; r0 = r0 < 0 ? 0 : (r0 > 120 ? 120 : r0);
    int jlo = 4 * rblk - 4; jlo = jlo < 0 ? 0 : (jlo > 120 ? 120 : jlo);
    int jhi = 4 * rblk - 1; jhi = (jhi < 0 ? 0 : (jhi > 120 ? 120 : jhi)) + 7;
    const int NT = jhi - jlo + 2;
    const size_t mrow = (size_t)b * SEQ + 64 * rq + c;
    const bf16_t* Qp = P.Q + mrow * 1024 + h * 64;
    bf16x8 qr[4];
#pragma unroll
    for (int d0 = 0; d0 < 4; ++d0) qr[d0] = *(const bf16x8*)(Qp + d0 * 16 + hi * 8);
    asm volatile("s_waitcnt vmcnt(0)" : "+v"(qr[0]), "+v"(qr[1]), "+v"(qr[2]), "+v"(qr[3]) :: "memory");
    const int kcol = h * 64;
    const bf16_t* kreal = P.K + ((size_t)b * SEQ + (size_t)jlo * 64) * 1024 + kcol + (size_t)lane * 1024 + wid * 8;
    const bf16_t* kmeta = P.Kmeta + kcol + (size_t)lane * 1024 + wid * 8;
    const int vro = (16 * (wid & 3) + (lane >> 2)) * 1024 + (lane & 3) * 8 + 32 * (wid >> 2);
    const bf16_t* vreal = P.V + ((size_t)b * SEQ + (size_t)jlo * 64) * 1024 + kcol + vro;
    const bf16_t* vmeta = P.Vmeta + kcol + vro;
    const lds_cptr vl0 = ldsc + LDS_V + ((lane >> 4) & 1) * 32 + (lane & 3) * 8 + (4 * hi + ((lane & 15) >> 2)) * 64;
#define NA_DMA(t, slot) do { const int t_ = (t); const unsigned so_ = (unsigned)(slot); \
    const bf16_t* ks_ = t_ == NT - 1 ? kmeta : kreal + (size_t)t_ * 65536; const bf16_t* vs_ = t_ == NT - 1 ? vmeta : vreal + (size_t)t_ * 65536; \
    glds16(ks_, (unsigned)__builtin_amdgcn_readfirstlane(lds0 + LDS_K + so_ * KSLOT + wid * 1024)); \
    glds16(vs_, (unsigned)__builtin_amdgcn_readfirstlane(lds0 + LDS_V + so_ * VSLOT + wid * 1024)); } while (0)
    f32x16 oT[2];
#pragma unroll
    for (int db = 0; db < 2; ++db)
#pragma unroll
        for (int r = 0; r < 16; ++r) oT[db][r] = 0.f;
    float mref = 0.f, lsum = 0.f;
    f32x16 ma0, ma1;
#pragma unroll
    for (int r = 0; r < 16; ++r) { const int cr = (r & 3) + 8 * (r >> 2) + 4 * hi - cs;
        ma0[r] = ((unsigned)cr < 16u) ? 0.f : NEGBIG; ma1[r] = ((unsigned)(cr + 32) < 16u) ? 0.f : NEGBIG; }
    NA_DMA(0, 0); NA_DMA(1, 1);
    int sl = 0, sl2 = 2;
#pragma unroll 1
    for (int t = 0; t < NT; ++t) {
        if (t + 1 < NT) ATT_WAIT_BAR(2); else ATT_WAIT_BAR(0);
        if (t + 2 < NT) NA_DMA(t + 2, sl2);
        const int jr = jlo + t; const bool meta = (t == NT - 1);
        if (meta || (jr >= r0 && jr < r0 + 8)) {
            const ATT_LAS float* tb = tbl + 64 + (jr - rq + 7) * 31 + 4 * hi - c + 15;
            if (meta) na_tile<2>(ldsc + LDS_K + sl * KSLOT, vl0 + sl * VSLOT, qr, oT, mref, lsum, ma0, ma1, tb, r32, hi);
            else if (wid & 1) na_tile<1>(ldsc + LDS_K + sl * KSLOT, vl0 + sl * VSLOT, qr, oT, mref, lsum, ma0, ma1, tb, r32, hi);
            else na_tile<0>(ldsc + LDS_K + sl * KSLOT, vl0 + sl * VSLOT, qr, oT, mref, lsum, ma0, ma1, tb, r32, hi);
        }
        sl = (sl == 2) ? 0 : sl + 1; sl2 = (sl2 == 2) ? 0 : sl2 + 1;
    }
    ATT_WAIT_BAR(0);
#undef NA_DMA
    const float l = lsum + __shfl_xor(lsum, 32), inv = __builtin_amdgcn_rcpf(l);
    bf16_t* Op = P.O + mrow * 1024 + h * 64;
#pragma unroll
    for (int db = 0; db < 2; ++db) store_block_w16(Op + 32 * db, oT[db], inv, hi);
    asm volatile("s_waitcnt vmcnt(0)" ::: "memory");
}
}


constexpr int NWAVES = 8;
#ifndef MK_N_LAUNCHES
#define MK_N_LAUNCHES 1
#endif
constexpr int N_LAUNCHES = MK_N_LAUNCHES, N_PHASES = 11;

constexpr size_t MiB = 1u << 20;
constexpr size_t WS_CTL = 0, CTL_ZERO_BYTES = 1 * MiB;
constexpr size_t WS_WIN_T = 2 * MiB;
constexpr size_t WS_WBDA_T = 42 * MiB, WS_WBNA_T = 46 * MiB;
constexpr size_t WS_WOUT_T = 50 * MiB, WS_WQ_T = 58 * MiB;
constexpr size_t WS_SK = 66 * MiB;
constexpr size_t WS_XNM = 66 * MiB + 64 * 1024;
constexpr size_t WS_METAKV = 66 * MiB + 128 * 1024;
constexpr size_t METAKV_BLK = 64 * 1024 * 2;
constexpr size_t WS_SSP = 67 * MiB;
constexpr size_t WS_UV6 = 70 * MiB;
constexpr size_t WS_SCL = 118 * MiB;
constexpr size_t WS_U6S = 120 * MiB, WS_V6S = 144 * MiB;
constexpr size_t WS_SELE = 168 * MiB;
constexpr size_t WS_SELG = 172 * MiB;
constexpr size_t WS_PW = 180 * MiB;
constexpr size_t WS_PART = 198 * MiB;
constexpr size_t WS_XN = 198 * MiB;
constexpr size_t WS_OC = WS_XN;
constexpr size_t WS_ODA = WS_XN, WS_ONA = 454 * MiB;
constexpr size_t WS_QDA = 262 * MiB, WS_KDA = 294 * MiB, WS_VDA = 326 * MiB, WS_QNA = 358 * MiB, WS_KNA = 390 * MiB, WS_VNA = 422 * MiB;
constexpr size_t WS_END = 486 * MiB;
constexpr size_t WS_Y1 = WS_QDA;
constexpr size_t WS_MIX = WS_VDA;
constexpr size_t WS_H2G = WS_KNA;
constexpr size_t WS_PQ = WS_QDA;
constexpr int CW_BAR = 4096, CW_QUEUE = 8192;

constexpr int RING_OFF = 0, RING_BYTES = 131072;
constexpr int LDSCTL_OFF = 143360, MISC_OFF = LDSCTL_OFF + 320;
constexpr int LDS_BYTES = 147456;
static_assert(MISC_OFF + 128 <= LDS_BYTES && att::LDS_BYTES <= LDSCTL_OFF && RING_BYTES <= LDSCTL_OFF, "LDS map");

#define GAS __attribute__((address_space(1)))
#define LAS __attribute__((address_space(3)))
typedef unsigned short bf16;
typedef unsigned v4u __attribute__((ext_vector_type(4)));
typedef unsigned v2u __attribute__((ext_vector_type(2)));
typedef float f32x4 __attribute__((ext_vector_type(4)));
typedef float f32x2 __attribute__((ext_vector_type(2)));
typedef float f32x16 __attribute__((ext_vector_type(16)));
typedef short bf16x8 __attribute__((ext_vector_type(8)));
typedef __bf16 bf16x2_t __attribute__((ext_vector_type(2)));
typedef GAS unsigned gu32;
#define RLX_AGENT __ATOMIC_RELAXED, __HIP_MEMORY_SCOPE_AGENT
#define LDS_WAIT() asm volatile("s_waitcnt lgkmcnt(0)" ::: "memory")
#define VM_WAIT() asm volatile("s_waitcnt vmcnt(0)" ::: "memory")
__device__ __forceinline__ unsigned f2bf(float f) { unsigned u = __builtin_bit_cast(unsigned, f); return (u + 0x7fffu + ((u >> 16) & 1u)) >> 16; }
__device__ __forceinline__ unsigned pk2(float lo, float hi) { return f2bf(lo) | (f2bf(hi) << 16); }

#define XB_TMO      128
#define XB_XCNT(j)  (256  + 64 * (j))
#define XB_XSUB(j)  (1280 + 64 * (j))
#define XB_XGEN(j)  (2304 + 64 * (j))
#define XB_TOP      3328
#define XB_TOPGEN   3392
#define XCD_BAR_WORDS 3456
#define XB_SPIN_CAP (1u << 22)

__device__ __forceinline__ unsigned xb_ld(unsigned* p)              { return __hip_atomic_load(p, __ATOMIC_RELAXED, __HIP_MEMORY_SCOPE_AGENT); }
__device__ __forceinline__ unsigned xb_add(unsigned* p, unsigned v) { return __hip_atomic_fetch_add(p, v, __ATOMIC_RELAXED, __HIP_MEMORY_SCOPE_AGENT); }
__device__ __forceinline__ unsigned xb_xcc_id() { return (unsigned)__builtin_amdgcn_s_getreg((3 << 11) | 20) & 0xFu; }
#define XB_SPIN(cond, bar) do { unsigned _sp = 0; while (cond) { __builtin_amdgcn_s_sleep(1); \
    if ((++_sp & 255u) == 0u) { if (xb_ld(&(bar)[XB_TMO])) break; if (_sp > XB_SPIN_CAP) { atomicAdd(&(bar)[XB_TMO], 1u); break; } } } } while (0)

struct XcdBarrier { unsigned* bar; unsigned x; volatile LAS unsigned* st; };

__device__ __forceinline__ XcdBarrier xcd_barrier_post(unsigned* bar, volatile LAS unsigned* st) {
    XcdBarrier b; b.bar = bar; b.x = xb_xcc_id(); b.st = st;
    if (threadIdx.x == 0) (void)xb_add(&bar[XB_XCNT(b.x)], 1u);
    return b;
}
__device__ __forceinline__ void xcd_barrier_complete(unsigned* bar, unsigned x, unsigned& nloc, unsigned& nx) {
    const unsigned G = gridDim.x * gridDim.y * gridDim.z;
    unsigned sum, cnt, mine, sp = 0u;
    for (;;) {
        sum = 0u; cnt = 0u; mine = 0u;
#pragma unroll
        for (unsigned j = 0; j < 16; ++j) { const unsigned c = xb_ld(&bar[XB_XCNT(j)]); sum += c; cnt += (c > 0u) ? 1u : 0u; mine = (j == x) ? c : mine; }
        if (sum == G) break;
        __builtin_amdgcn_s_sleep(1);
        if ((++sp & 255u) == 0u) { if (xb_ld(&bar[XB_TMO])) break; if (sp > XB_SPIN_CAP) { atomicAdd(&bar[XB_TMO], 1u); break; } }
    }
    nloc = mine > 0u ? mine : 1u; nx = cnt > 0u ? cnt : 1u;
}
__device__ __forceinline__ void xcd_barrier(const XcdBarrier& b) {
    asm volatile("s_waitcnt vmcnt(0)" ::: "memory");
    __syncthreads();
    if (threadIdx.x == 0) {
        unsigned* bar = b.bar;
        __builtin_amdgcn_s_waitcnt(0);
        unsigned nloc = b.st[0], nx = b.st[1];
        if (nloc == 0u) { xcd_barrier_complete(bar, b.x, nloc, nx); b.st[0] = nloc; b.st[1] = nx; }
        const unsigned old = xb_add(&bar[XB_XSUB(b.x)], 1u);
        const unsigned gen = old / nloc;
        if (old + 1u == (gen + 1u) * nloc) {
            __builtin_amdgcn_fence(__ATOMIC_RELEASE, "agent");
            asm volatile("s_waitcnt vmcnt(0)" ::: "memory");
            const unsigned og = xb_add(&bar[XB_TOP], 1u);
            const unsigned tg = og / nx;
            if (og + 1u == (tg + 1u) * nx) xb_add(&bar[XB_TOPGEN], 1u);
            else XB_SPIN(xb_ld(&bar[XB_TOPGEN]) == tg, bar);
            __builtin_amdgcn_fence(__ATOMIC_ACQUIRE, "agent");
            xb_add(&bar[XB_XGEN(b.x)], 1u);
            asm volatile("s_waitcnt vmcnt(0)" ::: "memory");
        } else {
            XB_SPIN(xb_ld(&bar[XB_XGEN(b.x)]) == gen, bar);
            __builtin_amdgcn_fence(__ATOMIC_ACQUIRE, "agent");
            asm volatile("s_waitcnt vmcnt(0)" ::: "memory");
        }
    }
    __syncthreads();
}

struct Frame {
    LAS unsigned char* lds;
    volatile LAS unsigned* MISC;
    int tid, lane, wave;
    int vcu, G;
};

__device__ __forceinline__ float wave_sum(float v) {
#pragma unroll
    for (int o = 1; o < 64; o <<= 1) v += __shfl_xor(v, o);
    return v;
}
__device__ __forceinline__ float wave_sum_dpp(float v) {
#define DPPF(x, ctrl, rmask, bc) __builtin_bit_cast(float, __builtin_amdgcn_update_dpp(0, __builtin_bit_cast(int, (x)), (ctrl), (rmask), 0xf, (bc)))
    v += DPPF(v, 0x111, 0xf, true); v += DPPF(v, 0x112, 0xf, true); v += DPPF(v, 0x114, 0xf, true); v += DPPF(v, 0x118, 0xf, true);
    v += DPPF(v, 0x142, 0xa, false);
    v += DPPF(v, 0x143, 0xc, false);
#undef DPPF
    return __builtin_bit_cast(float, __builtin_amdgcn_readlane(__builtin_bit_cast(int, v), 63));
}
__device__ __forceinline__ int win_row_of_col(int c) {
    const int pn = c >> 8, cc = c & 255;
    const bool normtile = (pn < 8) || (pn >= 12 && pn < 20);
    if (normtile) return (pn << 8) + 128 * ((cc >> 5) & 1) + 32 * (cc >> 6) + (cc & 31);
    return c;
}
template <bool PERMUTE>
__device__ __forceinline__ void p0_transpose_item(const float* W, int K, int N, bf16* WT, LAS float* scr, int item, int lane) {
    const int nblk = N / 32, kb = item / nblk, nb = item % nblk, k0 = 64 * kb, n0 = 32 * nb;
    const int r0 = PERMUTE ? win_row_of_col(n0) : n0;
#pragma unroll 8
    for (int i = 0; i < 32; ++i) { const int kk = 2 * i + (lane >> 5); scr[kk * 33 + (lane & 31)] = W[(size_t)(k0 + kk) * N + n0 + (lane & 31)]; }
    LDS_WAIT(); asm volatile("" ::: "memory");
    const int c = lane & 7;
#pragma unroll
    for (int j = 0; j < 4; ++j) { const int n = (lane >> 3) + 8 * j; const LAS float* s = scr + (8 * c) * 33 + n;
        v4u o; o.x = pk2(s[0 * 33], s[1 * 33]); o.y = pk2(s[2 * 33], s[3 * 33]); o.z = pk2(s[4 * 33], s[5 * 33]); o.w = pk2(s[6 * 33], s[7 * 33]);
        *(GAS v4u*)(WT + (size_t)(r0 + n) * K + k0 + 8 * c) = o; }
    LDS_WAIT(); asm volatile("" ::: "memory");
}
__device__ __forceinline__ void rms_row_to_bf16(const float* xrow, const float* g, bf16* orow, int lane) {
    const GAS f32x4* xr = (const GAS f32x4*)xrow + lane; const GAS f32x4* gr = (const GAS f32x4*)g + lane;
    f32x4 v[8]; float s = 0.f;
#pragma unroll
    for (int j = 0; j < 8; ++j) { v[j] = xr[64 * j]; s += (v[j].x * v[j].x + v[j].y * v[j].y) + (v[j].z * v[j].z + v[j].w * v[j].w); }
    const float rstd = __builtin_amdgcn_rsqf(wave_sum(s) * (1.f / DM) + EPS);
    GAS unsigned long long* o8 = (GAS unsigned long long*)orow + lane;
#pragma unroll
    for (int j = 0; j < 8; ++j) { const f32x4 gg = gr[64 * j];
        o8[64 * j] = (unsigned long long)pk2(v[j].x * rstd * gg.x, v[j].y * rstd * gg.y) | ((unsigned long long)pk2(v[j].z * rstd * gg.z, v[j].w * rstd * gg.w) << 32); }
}

typedef float f32x16v __attribute__((ext_vector_type(16)));
typedef float f32x32v __attribute__((ext_vector_type(32)));
typedef unsigned v6u __attribute__((ext_vector_type(6)));
__device__ __forceinline__ void fp6_row(const float* src, unsigned char* rec, float* scl, int lane) {
    f32x4 v[8]; float am = 0.f;
#pragma unroll
    for (int q = 0; q < 8; ++q) { v[q] = *(const GAS f32x4*)(src + 32 * lane + 4 * q);
        am = __builtin_fmaxf(am, __builtin_fmaxf(__builtin_fmaxf(__builtin_fabsf(v[q].x), __builtin_fabsf(v[q].y)), __builtin_fmaxf(__builtin_fabsf(v[q].z), __builtin_fabsf(v[q].w)))); }
#pragma unroll
    for (int o = 1; o < 64; o <<= 1) am = __builtin_fmaxf(am, __shfl_xor(am, o));
    am = __builtin_fmaxf(am, 1.0e-30f);
    const float sc = 7.5f / am;
    f32x16v lo, hi;
#pragma unroll
    for (int q = 0; q < 8; ++q) { lo[2 * q] = v[q].x * sc; hi[2 * q] = v[q].y * sc; lo[2 * q + 1] = v[q].z * sc; hi[2 * q + 1] = v[q].w * sc; }
    const v6u p = __builtin_amdgcn_cvt_scalef32_2xpk16_fp6_f32(lo, hi, 1.0f);
    *(GAS v4u*)(rec + lane * 16) = (v4u){p[0], p[1], p[2], p[3]};
    *(GAS v2u*)(rec + 1024 + lane * 8) = (v2u){p[4], p[5]};
    if (lane == 0) *scl = am * (1.0f / 7.5f);
}
__device__ __forceinline__ void fp6_row_sliced(const float* src, unsigned char* tab, int e, float* scl, int lane) {
    f32x4 v[8]; float am = 0.f;
#pragma unroll
    for (int q = 0; q < 8; ++q) { v[q] = *(const GAS f32x4*)(src + 32 * lane + 4 * q);
        am = __builtin_fmaxf(am, __builtin_fmaxf(__builtin_fmaxf(__builtin_fabsf(v[q].x), __builtin_fabsf(v[q].y)), __builtin_fmaxf(__builtin_fabsf(v[q].z), __builtin_fabsf(v[q].w)))); }
#pragma unroll
    for (int o = 1; o < 64; o <<= 1) am = __builtin_fmaxf(am, __shfl_xor(am, o));
    am = __builtin_fmaxf(am, 1.0e-30f);
    const float sc = 7.5f / am;
    f32x16v lo, hi;
#pragma unroll
    for (int q = 0; q < 8; ++q) { lo[2 * q] = v[q].x * sc; hi[2 * q] = v[q].y * sc; lo[2 * q + 1] = v[q].z * sc; hi[2 * q + 1] = v[q].w * sc; }
    const v6u p = __builtin_amdgcn_cvt_scalef32_2xpk16_fp6_f32(lo, hi, 1.0f);
    unsigned char* sl = tab + (size_t)(lane >> 3) * (16384 * 192);
    *(GAS v4u*)(sl + (size_t)e * 128 + (lane & 7) * 16) = (v4u){p[0], p[1], p[2], p[3]};
    *(GAS v2u*)(sl + 16384 * 128 + (size_t)e * 64 + (lane & 7) * 8) = (v2u){p[4], p[5]};
    if (lane == 0) *scl = am * (1.0f / 7.5f);
}
__device__ __forceinline__ void meta_proj(Frame& F, const bf16* XNM, const bf16* WinT, bf16* metakv, const float* gk_da, const float* gk_na, int j) {
    const int s = j >> 4, gi = j & 15;
    const int cbase = (s == 0) ? 1024 : (s == 1) ? 2048 : (s == 2) ? 4096 : 5120;
    const int c0 = cbase + 64 * gi;
    const int l15 = F.lane & 15, kq = F.lane >> 4, w = F.wave;
    f32x4 acc[4];
#pragma unroll
    for (int t = 0; t < 4; ++t) acc[t] = (f32x4){0.f, 0.f, 0.f, 0.f};
    const bf16* ap = XNM + (size_t)l15 * 2048 + 256 * w + 8 * kq;
    const bf16* bp[4];
#pragma unroll
    for (int t = 0; t < 4; ++t) bp[t] = WinT + (size_t)win_row_of_col(c0 + 16 * t + l15) * 2048 + 256 * w + 8 * kq;
#pragma unroll
    for (int ks = 0; ks < 8; ++ks) { const bf16x8 a = *(const GAS bf16x8*)(ap + 32 * ks);
#pragma unroll
        for (int t = 0; t < 4; ++t) { const bf16x8 b = *(const GAS bf16x8*)(bp[t] + 32 * ks); acc[t] = __builtin_amdgcn_mfma_f32_16x16x32_bf16(a, b, acc[t], 0, 0, 0); } }
    LAS float* part = (LAS float*)(F.lds + RING_OFF);
    LAS float* res = part + 8 * 16 * 64;
#pragma unroll
    for (int t = 0; t < 4; ++t)
#pragma unroll
        for (int r = 0; r < 4; ++r) part[(w * 16 + 4 * kq + r) * 64 + 16 * t + l15] = acc[t][r];
    __syncthreads();
#pragma unroll
    for (int q = 0; q < 2; ++q) { const int o = F.tid * 2 + q; float v = 0.f;
#pragma unroll
        for (int ww = 0; ww < 8; ++ww) v += part[ww * 1024 + o];
        res[o] = v; }
    __syncthreads();
    { const int token = 2 * w + (F.lane >> 5), cc = 2 * (F.lane & 31);
      float v0 = res[token * 64 + cc], v1 = res[token * 64 + cc + 1];
      if (s == 0 || s == 2) { float ss = v0 * v0 + v1 * v1;
#pragma unroll
          for (int o = 1; o < 32; o <<= 1) ss += __shfl_xor(ss, o);
          const float rs = __builtin_amdgcn_rsqf(ss * (1.0f / 64.0f) + EPS); const float* g = (s == 0) ? gk_da : gk_na;
          v0 *= rs * g[cc]; v1 *= rs * g[cc + 1]; }
      bf16* dst = metakv + (size_t)s * (64 * 1024) + (size_t)(48 + token) * 1024 + 64 * gi + cc;
      *(GAS unsigned*)dst = pk2(v0, v1); }
    __syncthreads();
}

__device__ __forceinline__ int f2ord(float f) { const int i = __builtin_bit_cast(int, f); return i ^ ((i >> 31) & 0x7fffffff); }
__device__ __forceinline__ float ord2f(int i) { return __builtin_bit_cast(float, i ^ ((i >> 31) & 0x7fffffff)); }
#define TOPK_INS(L, x) do { int v_ = (x); _Pragma("unroll") for (int i_ = 0; i_ < 16; ++i_) { const int t_ = max(L[i_], v_); v_ = min(L[i_], v_); L[i_] = t_; } } while (0)
__device__ __forceinline__ float gelu_tanh(float a) {
    const float z = 0.7978845608028654f * (a + 0.044715f * a * a * a);
    const float e = __builtin_amdgcn_exp2f(z * (2.0f * LOG2E));
    const float th = 1.0f - 2.0f * __builtin_amdgcn_rcpf(e + 1.0f);
    return 0.5f * a * (1.0f + th);
}
constexpr int PEER_TOK = 32;
constexpr int PL_SELE = 0, PL_SELG = 8192, PL_SET = 24576, PL_IDX = 2 * PL_SET;

#define CE_DESC(a, b) do { const int hi_ = max((a), (b)); const int lo_ = min((a), (b)); (a) = hi_; (b) = lo_; } while (0)
__device__ __forceinline__ void sort16_desc(int (&v)[16]) {
#pragma unroll
    for (int k = 2; k <= 16; k <<= 1)
#pragma unroll
        for (int j = k >> 1; j > 0; j >>= 1)
#pragma unroll
            for (int i = 0; i < 16; ++i) { const int l = i ^ j; if (l > i) { if ((i & k) == 0) CE_DESC(v[i], v[l]); else CE_DESC(v[l], v[i]); } }
}
__device__ __forceinline__ void merge16_desc(int (&a)[16], const int (&b)[16]) {
#pragma unroll
    for (int i = 0; i < 16; ++i) a[i] = max(a[i], b[15 - i]);
#pragma unroll
    for (int j = 8; j > 0; j >>= 1)
#pragma unroll
        for (int i = 0; i < 16; ++i) { const int l = i ^ j; if (l > i) CE_DESC(a[i], a[l]); }
}
__device__ __forceinline__ void peer_retrieve(Frame& F, const bf16* PQ, const bf16* SK, unsigned short* SELE, float* SELG, int tile) {
    const int t0 = tile * PEER_TOK, lane = F.lane, r32 = lane & 31, hi = lane >> 5, h = F.wave;
    int L0[16], L1[16];
    int hi4 = 4 * hi; asm volatile("" : "+v"(hi4));
#pragma unroll
    for (int p = 0; p < 2; ++p) {
        f32x16 acc[4];
#pragma unroll
        for (int rt = 0; rt < 4; ++rt)
#pragma unroll
            for (int r = 0; r < 16; ++r) acc[rt][r] = 0.f;
        const bf16* qp = PQ + (size_t)(t0 + r32) * 2048 + h * 256 + p * 128 + hi * 8;
        const bf16* skp = SK + (size_t)p * 16384 + (size_t)r32 * 128 + hi * 8;
        asm volatile("" : "+v"(qp), "+v"(skp));
#pragma unroll
        for (int ks = 0; ks < 8; ++ks) { const bf16x8 bq = *(const GAS bf16x8*)(qp + 16 * ks);
#pragma unroll
            for (int rt = 0; rt < 4; ++rt) { const bf16x8 a = *(const GAS bf16x8*)(skp + rt * 4096 + 16 * ks); acc[rt] = __builtin_amdgcn_mfma_f32_32x32x16_bf16(a, bq, acc[rt], 0, 0, 0); } }
        int L[16];
        {
            int G1[16], G2[16], G3[16];
#pragma unroll
            for (int r = 0; r < 16; ++r) {
                L[r] = ((f2ord(acc[0][r]) & ~127) | hi4) | (0 + (r & 3) + 8 * (r >> 2)); G1[r] = ((f2ord(acc[1][r]) & ~127) | hi4) | (32 + (r & 3) + 8 * (r >> 2));
                G2[r] = ((f2ord(acc[2][r]) & ~127) | hi4) | (64 + (r & 3) + 8 * (r >> 2)); G3[r] = ((f2ord(acc[3][r]) & ~127) | hi4) | (96 + (r & 3) + 8 * (r >> 2)); }
            sort16_desc(L); sort16_desc(G1); merge16_desc(L, G1);
            sort16_desc(G2); sort16_desc(G3); merge16_desc(G2, G3);
            merge16_desc(L, G2);
        }
        int O[16];
#pragma unroll
        for (int i = 0; i < 16; ++i) O[i] = __shfl_xor(L[i], 32);
        merge16_desc(L, O);
#pragma unroll
        for (int i = 0; i < 16; ++i) { if (p == 0) L0[i] = L[i]; else L1[i] = L[i]; }
    }
    int C[16];
#define CKEY(i_, j_) ((f2ord(ord2f(L0[i_] & ~127) + ord2f(L1[j_] & ~127)) & ~255) | ((i_) << 4) | (15 - (j_)))
    {
#pragma unroll
        for (int j = 0; j < 16; ++j) C[j] = CKEY(0, j);
#pragma unroll
        for (int j = 8; j < 16; ++j) C[j] = max(C[j], CKEY(1, 15 - j));
#pragma unroll
        for (int jj = 8; jj > 0; jj >>= 1)
#pragma unroll
            for (int i = 0; i < 16; ++i) { const int l = i ^ jj; if (l > i) CE_DESC(C[i], C[l]); }
        int X[16] = {CKEY(2, 0), CKEY(2, 1), CKEY(2, 2), CKEY(2, 3), CKEY(2, 4), CKEY(3, 0), CKEY(3, 1), CKEY(3, 2), CKEY(3, 3), CKEY(4, 0), CKEY(4, 1), CKEY(4, 2), CKEY(5, 0), CKEY(5, 1), CKEY(6, 0), CKEY(6, 1)};
        sort16_desc(X); merge16_desc(C, X);
        int Y[16] = {CKEY(7, 0), CKEY(7, 1), CKEY(8, 0), CKEY(9, 0), CKEY(10, 0), CKEY(11, 0), CKEY(12, 0), CKEY(13, 0), CKEY(14, 0), CKEY(15, 0),
                     (int)0x80000000, (int)0x80000000, (int)0x80000000, (int)0x80000000, (int)0x80000000, (int)0x80000000};
        sort16_desc(Y); merge16_desc(C, Y);
    }
#undef CKEY
    LAS unsigned* ix = (LAS unsigned*)(F.lds + PL_IDX + F.tid * 32);
#pragma unroll
    for (int q = 0; q < 4; ++q) {
        ix[q] = (unsigned)(L0[4 * q] & 127) | ((unsigned)(L0[4 * q + 1] & 127) << 8) | ((unsigned)(L0[4 * q + 2] & 127) << 16) | ((unsigned)(L0[4 * q + 3] & 127) << 24);
        ix[4 + q] = (unsigned)(L1[4 * q] & 127) | ((unsigned)(L1[4 * q + 1] & 127) << 8) | ((unsigned)(L1[4 * q + 2] & 127) << 16) | ((unsigned)(L1[4 * q + 3] & 127) << 24); }
    const LAS unsigned char* ixb = (const LAS unsigned char*)ix;
    float sc[16]; float sum = 0.f;
#pragma unroll
    for (int k = 0; k < 16; ++k) sc[k] = ord2f(C[k] & ~255);
    const float mx = sc[0];
#pragma unroll
    for (int k = 0; k < 16; ++k) { sc[k] = __builtin_amdgcn_exp2f((sc[k] - mx) * LOG2E); sum += sc[k]; }
    const float rsum = 1.0f / sum;
    if (hi == 0) {
        unsigned ew[8];
#pragma unroll
        for (int k = 0; k < 16; ++k) { const int ij = C[k] & 255; const unsigned e = (unsigned)ixb[ij >> 4] * 128u + (unsigned)ixb[16 + (15 - (ij & 15))];
            if (k & 1) ew[k >> 1] |= e << 16; else ew[k >> 1] = e; }
        GAS v4u* ep = (GAS v4u*)(SELE + (size_t)(t0 + r32) * 128 + h * 16);
        ep[0] = (v4u){ew[0], ew[1], ew[2], ew[3]}; ep[1] = (v4u){ew[4], ew[5], ew[6], ew[7]};
        GAS f32x4* gp = (GAS f32x4*)(SELG + (size_t)(t0 + r32) * 128 + h * 16);
#pragma unroll
        for (int q = 0; q < 4; ++q) gp[q] = (f32x4){sc[4 * q] * rsum, sc[4 * q + 1] * rsum, sc[4 * q + 2] * rsum, sc[4 * q + 3] * rsum};
    }
}

typedef float f32x2v __attribute__((ext_vector_type(2)));
typedef _Float16 h16x2 __attribute__((ext_vector_type(2)));
typedef _Float16 h16x32 __attribute__((ext_vector_type(32)));
template <int PASS>
__device__ __forceinline__ void peer_slice_pass(Frame& F, const unsigned char* TAB, const unsigned short* SELE, const float* PW, const bf16* H2G, float* PART, const float* g2, float* OUT) {
    const int x = (int)(blockIdx.x & 7), jb = (int)(blockIdx.x >> 3), JB = (F.G - x + 7) >> 3;
    const int lane = F.lane, grp = lane >> 3, s = lane & 7;
    LAS unsigned char* wl = F.lds + F.wave * 8192;
    const LAS unsigned short* LE = (const LAS unsigned short*)wl + grp * 128; LAS float* LW = (LAS float*)(wl + 2048) + grp * 128;
    const unsigned char* tab = TAB + (size_t)x * (16384 * 192);
    const unsigned o16 = 16u * s, o8 = 16384u * 128u + 8u * s;
#define DPPF(xx, ctrl) __builtin_bit_cast(float, __builtin_amdgcn_update_dpp(0, __builtin_bit_cast(int, (xx)), (ctrl), 0xf, 0xf, true))
#define PS_ISSUE(g_, A, B, W4) do { const v2u ids_ = *(const LAS v2u*)(LE + 4 * (g_)); if (PASS == 1) W4 = *(const LAS f32x4*)(LW + 4 * (g_)); \
        const unsigned e0_ = (ids_.x & 0xffffu) * 64u, e1_ = (ids_.x >> 16) * 64u, e2_ = (ids_.y & 0xffffu) * 64u, e3_ = (ids_.y >> 16) * 64u; \
        A[0] = *(const GAS v4u*)(tab + (2u * e0_ + o16)); B[0] = *(const GAS v2u*)(tab + (e0_ + o8)); A[1] = *(const GAS v4u*)(tab + (2u * e1_ + o16)); B[1] = *(const GAS v2u*)(tab + (e1_ + o8)); \
        A[2] = *(const GAS v4u*)(tab + (2u * e2_ + o16)); B[2] = *(const GAS v2u*)(tab + (e2_ + o8)); A[3] = *(const GAS v4u*)(tab + (2u * e3_ + o16)); B[3] = *(const GAS v2u*)(tab + (e3_ + o8)); } while (0)
#pragma unroll 1
    for (int tb = jb * NWAVES + F.wave; tb < M / 8; tb += JB * NWAVES) {
        const size_t t = (size_t)tb * 8 + grp;
        { const GAS v4u* sp = (const GAS v4u*)(SELE + (size_t)tb * 1024) + lane * 2; const v4u a = sp[0], b = sp[1];
          *(LAS v4u*)(wl + lane * 32) = a; *(LAS v4u*)(wl + lane * 32 + 16) = b; }
        if (PASS == 1) { const GAS f32x4* wp = (const GAS f32x4*)(PW + (size_t)tb * 1024) + lane * 4;
#pragma unroll
            for (int q = 0; q < 4; ++q) *(LAS f32x4*)(wl + 2048 + lane * 64 + 16 * q) = wp[q]; }
        const bf16* xp = H2G + t * 2048 + 256 * x + 32 * s;
        f32x2v xv[16];
        h16x2 xh[16];
        if (PASS == 0) {
#pragma unroll
            for (int q = 0; q < 4; ++q) { const v4u w = *(const GAS v4u*)(xp + 8 * q);
                xh[4 * q] = __builtin_bit_cast(h16x2, __builtin_amdgcn_cvt_pkrtz(pg8::bf_lo(w.x), pg8::bf_hi(w.x))); xh[4 * q + 1] = __builtin_bit_cast(h16x2, __builtin_amdgcn_cvt_pkrtz(pg8::bf_lo(w.y), pg8::bf_hi(w.y)));
                xh[4 * q + 2] = __builtin_bit_cast(h16x2, __builtin_amdgcn_cvt_pkrtz(pg8::bf_lo(w.z), pg8::bf_hi(w.z))); xh[4 * q + 3] = __builtin_bit_cast(h16x2, __builtin_amdgcn_cvt_pkrtz(pg8::bf_lo(w.w), pg8::bf_hi(w.w))); }
        } else {
#pragma unroll
            for (int j = 0; j < 16; ++j) { xv[j] = (f32x2v){0.f, 0.f}; xh[j] = (h16x2){(_Float16)0.f, (_Float16)0.f}; }
        }
        asm volatile("" ::: "memory");
        v4u a0[4], a1[4]; v2u b0[4], b1[4]; f32x4 w0, w1;
        PS_ISSUE(0, a0, b0, w0);
        __builtin_amdgcn_sched_barrier(0);
#pragma unroll 1
        for (int g = 0; g < 32; g += 2) {
            PS_ISSUE(g + 1, a1, b1, w1);
            __builtin_amdgcn_sched_barrier(0);
#pragma unroll
            for (int half = 0; half < 2; ++half) {
                float d[4];
#pragma unroll
                for (int i = 0; i < 4; ++i) {
                    const v4u A = half ? a1[i] : a0[i]; const v2u B = half ? b1[i] : b0[i];
                    const h16x32 r = __builtin_amdgcn_cvt_scalef32_pk32_f16_fp6((v6u){A.x, A.y, A.z, A.w, B.x, B.y}, 1.0f);
                    if (PASS == 0) {
                        const h16x2 hz = (h16x2){(_Float16)0.f, (_Float16)0.f}; h16x2 p0 = hz, p1 = hz, p2 = hz, p3 = hz;
#pragma unroll
                        for (int j = 0; j < 16; j += 4) {
                            p0 = __builtin_elementwise_fma((h16x2){r[2 * j], r[2 * j + 1]}, xh[j], p0); p1 = __builtin_elementwise_fma((h16x2){r[2 * j + 2], r[2 * j + 3]}, xh[j + 1], p1);
                            p2 = __builtin_elementwise_fma((h16x2){r[2 * j + 4], r[2 * j + 5]}, xh[j + 2], p2); p3 = __builtin_elementwise_fma((h16x2){r[2 * j + 6], r[2 * j + 7]}, xh[j + 3], p3); }
                        const h16x2 ps = (p0 + p1) + (p2 + p3);
                        d[i] = (float)ps.x + (float)ps.y;
                    } else {
                        const float w = half ? w1[i] : w0[i]; const h16x2 ww = __builtin_bit_cast(h16x2, __builtin_amdgcn_cvt_pkrtz(w, w));
#pragma unroll
                        for (int j = 0; j < 16; ++j) xh[j] = __builtin_elementwise_fma(ww, (h16x2){r[2 * j], r[2 * j + 1]}, xh[j]);
                    }
                }
                if (PASS == 1 && (((g + half) & 7) == 7)) {
#pragma unroll
                    for (int j = 0; j < 16; ++j) { xv[j] += (f32x2v){(float)xh[j].x, (float)xh[j].y}; xh[j] = (h16x2){(_Float16)0.f, (_Float16)0.f}; }
                }
                if (PASS == 0) {
#pragma unroll
                    for (int i = 0; i < 4; ++i) d[i] += DPPF(d[i], 0xB1);
#pragma unroll
                    for (int i = 0; i < 4; ++i) d[i] += DPPF(d[i], 0x4E);
#pragma unroll
                    for (int i = 0; i < 4; ++i) d[i] += DPPF(d[i], 0x141);
                    if (s == 0) *(LAS f32x4*)(LW + 4 * (g + half)) = (f32x4){d[0], d[1], d[2], d[3]};
                }
                if (half == 0) { __builtin_amdgcn_sched_barrier(0); PS_ISSUE((g + 2) & 31, a0, b0, w0); __builtin_amdgcn_sched_barrier(0); }
            }
        }
        asm volatile("" ::: "memory");
        if (PASS == 0) {
            GAS f32x4* pp = (GAS f32x4*)(PART + ((size_t)x * M + (size_t)tb * 8) * 128) + lane;
#pragma unroll
            for (int q = 0; q < 4; ++q) __builtin_nontemporal_store(*(const LAS f32x4*)(wl + 2048 + (q * 64 + lane) * 16), pp + q * 64);
        } else {
#pragma unroll
            for (int j = 0; j < 8; ++j) *(LAS f32x4*)(wl + lane * 128 + 16 * j) = (f32x4){xv[2 * j].x, xv[2 * j].y, xv[2 * j + 1].x, xv[2 * j + 1].y};
            asm volatile("" ::: "memory");
#pragma unroll
            for (int q = 0; q < 8; ++q) { const f32x4 a = *(const LAS f32x4*)(wl + (grp * 8 + q) * 128 + 16 * s);
                const size_t c0 = t * 2048 + 256 * x + 32 * q + 4 * s; const v2u w = *(const GAS v2u*)(H2G + c0); const f32x4 gq = *(const GAS f32x4*)(g2 + 256 * x + 32 * q + 4 * s);
                __builtin_nontemporal_store((f32x4){pg8::bf_lo(w.x) * __builtin_amdgcn_rcpf(gq[0]) + a[0], pg8::bf_hi(w.x) * __builtin_amdgcn_rcpf(gq[1]) + a[1],
                                                    pg8::bf_lo(w.y) * __builtin_amdgcn_rcpf(gq[2]) + a[2], pg8::bf_hi(w.y) * __builtin_amdgcn_rcpf(gq[3]) + a[3]}, (GAS f32x4*)(OUT + c0)); }
        }
        asm volatile("" ::: "memory");
    }
#undef PS_ISSUE
#undef DPPF
}

struct Args { const float* in[22]; float* out; unsigned char* ws; int ph_lo, ph_hi, li, pad; };
__global__ void __launch_bounds__(NWAVES * 64, 2) mk_fwd(Args args) {
    extern __shared__ __attribute__((aligned(16))) unsigned char lds[];
    Frame F;
    F.lds = (LAS unsigned char*)lds;
    F.MISC = (volatile LAS unsigned*)(F.lds + MISC_OFF);
    F.tid = threadIdx.x; F.lane = F.tid & 63; F.wave = __builtin_amdgcn_readfirstlane(F.tid >> 6);
    F.G = gridDim.x; { const int bx = blockIdx.x; F.vcu = (F.G % 8 == 0) ? (bx % 8) * (F.G / 8) + bx / 8 : bx; }
    unsigned char* ws = args.ws;
    gu32* ctl = (gu32*)(ws + WS_CTL);
    const float* x = args.in[0]; const float* meta_tok = args.in[1]; const float* g1 = args.in[2]; const float* w_in = args.in[3];
    const float* gq_da = args.in[4]; const float* gk_da = args.in[5];
    const float* lq1 = args.in[6]; const float* lk1 = args.in[7]; const float* lq2 = args.in[8]; const float* lk2 = args.in[9];
    const float* g_oda = args.in[10]; const float* gq_na = args.in[11]; const float* gk_na = args.in[12]; const float* rpb = args.in[13];
    const float* w_bda = args.in[14]; const float* w_bna = args.in[15]; const float* w_out = args.in[16]; const float* g2 = args.in[17];
    const float* w_pq = args.in[18]; const float* subk = args.in[19]; const float* pu = args.in[20]; const float* pv = args.in[21];
    float* OUT = args.out;
    bf16* WinT = (bf16*)(ws + WS_WIN_T); bf16* WbdaT = (bf16*)(ws + WS_WBDA_T); bf16* WbnaT = (bf16*)(ws + WS_WBNA_T); bf16* WoutT = (bf16*)(ws + WS_WOUT_T); bf16* WqT = (bf16*)(ws + WS_WQ_T);
    bf16* SK = (bf16*)(ws + WS_SK); bf16* XNM = (bf16*)(ws + WS_XNM); bf16* METAKV = (bf16*)(ws + WS_METAKV); float* SSP = (float*)(ws + WS_SSP);
    unsigned char* U6S = ws + WS_U6S; unsigned char* V6S = ws + WS_V6S; unsigned short* SELE = (unsigned short*)(ws + WS_SELE); float* SELG = (float*)(ws + WS_SELG); float* PW = (float*)(ws + WS_PW); float* PART = (float*)(ws + WS_PART);
    float* SCL = (float*)(ws + WS_SCL); bf16* XN = (bf16*)(ws + WS_XN); bf16* ODA = (bf16*)(ws + WS_ODA); bf16* ONA = (bf16*)(ws + WS_ONA); bf16* OC = (bf16*)(ws + WS_OC);
    bf16* QDA = (bf16*)(ws + WS_QDA); bf16* KDA = (bf16*)(ws + WS_KDA); bf16* VDA = (bf16*)(ws + WS_VDA); bf16* QNA = (bf16*)(ws + WS_QNA); bf16* KNA = (bf16*)(ws + WS_KNA); bf16* VNA = (bf16*)(ws + WS_VNA);
    bf16* Y1 = (bf16*)(ws + WS_Y1); bf16* MIX = (bf16*)(ws + WS_MIX); bf16* H2G = (bf16*)(ws + WS_H2G); bf16* PQ = (bf16*)(ws + WS_PQ);
    bf16* SGDA = (bf16*)OUT; bf16* SGNA = (bf16*)OUT + (size_t)M * 2048;

    for (int u = F.tid; u < (LDS_BYTES - LDSCTL_OFF) / 4; u += NWAVES * 64) ((LAS unsigned*)(F.lds + LDSCTL_OFF))[u] = 0u;
    __syncthreads();
    XcdBarrier bar; bar.bar = (unsigned*)(ctl + CW_BAR); bar.x = 0; bar.st = nullptr;
    if (N_LAUNCHES == 1) bar = xcd_barrier_post((unsigned*)(ctl + CW_BAR), F.MISC + 8);
#define GRID_BAR() do { if (N_LAUNCHES == 1) xcd_barrier(bar); } while (0)
    const int lo = args.ph_lo, hi = args.ph_hi;
#ifndef PH_MASK
#define PH_MASK 0x7ff
#endif
#define IN(k) (((PH_MASK >> (k)) & 1) && lo <= (k) && (k) < hi)
#define BOTH(k) (IN(k) && IN((k) + 1))

    if (IN(0)) {
        LAS float* scr = (LAS float*)(F.lds + RING_OFF + F.wave * 16384);
        const int gw = F.vcu * NWAVES + F.wave, NGW = F.G * NWAVES;
        constexpr int I_IN = (DM / 64) * (INCOLS / 32);
        for (int it = gw; it < I_IN; it += NGW) p0_transpose_item<true>(w_in, DM, INCOLS, WinT, scr, it, F.lane);
        for (int m = gw; m < M + NMETA; m += NGW) {
            if (m < M) rms_row_to_bf16(x + (size_t)m * DM, g1, XN + (size_t)m * DM, F.lane);
            else rms_row_to_bf16(meta_tok + (size_t)(m - M) * DM, g1, XNM + (size_t)(m - M) * DM, F.lane);
        }
        const size_t gtid = (size_t)F.vcu * (NWAVES * 64) + F.tid, gthreads = (size_t)F.G * (NWAVES * 64);
        for (size_t i = gtid; i < (size_t)4 * 48 * 128; i += gthreads) {
            const size_t blk = i / (48 * 128), rem = i % (48 * 128);
            *(GAS v4u*)(METAKV + blk * (64 * 1024) + rem * 8) = (v4u){0u, 0u, 0u, 0u};
        }
        if (BOTH(0)) GRID_BAR();
    }

    if (IN(1)) {
        if (F.vcu < 64) meta_proj(F, XNM, WinT, METAKV, gk_da, gk_na, F.vcu);
        pg8::Gemm g{XN, WinT, M, INCOLS, DM}; pg8::StaticOrder S; S.init(M, INCOLS, F.G, (int)blockIdx.x);
        pg8::EpiIn E{QDA, KDA, VDA, QNA, KNA, VNA, SGDA, SGNA, gq_da, gk_da, gq_na, gk_na};
        pg8::gemm_phase<pg8::EpiIn, pg8::StaticOrder, true, true>(F.lds + RING_OFF, g, S, E);
        if (BOTH(1)) GRID_BAR();
    }

    if (IN(2)) {
        const unsigned lds0 = (unsigned)(uintptr_t)lds;
        float Sb;
        { float a = __builtin_fabsf(gq_da[F.lane]), b = __builtin_fabsf(gk_da[F.lane]);
#pragma unroll
          for (int o = 1; o < 64; o <<= 1) { a = __builtin_fmaxf(a, __shfl_xor(a, o)); b = __builtin_fmaxf(b, __shfl_xor(b, o)); }
          Sb = 8.0f * a * b * 1.02f; }
        const att::DAParams DP{QDA, KDA, VDA, METAKV, METAKV + 64 * 1024, OC, Sb * LOG2E - 8.0f};
        const att::NAParams NP{QNA, KNA, VNA, METAKV + 2 * 64 * 1024, METAKV + 3 * 64 * 1024, ONA, rpb};
        volatile LAS unsigned* qslot = F.MISC + 16;
        for (;;) {
            if (F.tid == 0) *qslot = __hip_atomic_fetch_add((unsigned*)(ctl + CW_QUEUE), 1u, __ATOMIC_RELAXED, __HIP_MEMORY_SCOPE_AGENT);
            __syncthreads();
            const int u = (int)*qslot;
            __syncthreads();
            if (u >= 2048) break;
            const int grp = u >> 2, pos = u & 3;
            if (pos == 3) {
                int ln = F.lane, tdx = F.tid; asm volatile("" : "+v"(ln), "+v"(tdx));
#pragma unroll 1
                for (int i = 0; i < 8; ++i) { const int r = grp * 64 + F.wave * 8 + i, e = r >> 1, isv = r & 1;
                    fp6_row_sliced((isv ? pv : pu) + (size_t)e * 2048, isv ? V6S : U6S, e, SCL + 2 * e + isv, ln); }
                constexpr int I_B = (1024 / 64) * (DM / 32), I_O = (DM / 64) * (DM / 32);
                LAS float* scr = (LAS float*)(F.lds + RING_OFF + F.wave * 16384);
#pragma unroll 1
                for (int i = F.wave; i < 12; i += NWAVES) { int r = grp * 12 + i;
                    if (r < I_B) { p0_transpose_item<false>(w_bda, 1024, DM, WbdaT, scr, r, ln); continue; } r -= I_B;
                    if (r < I_B) { p0_transpose_item<false>(w_bna, 1024, DM, WbnaT, scr, r, ln); continue; } r -= I_B;
                    if (r < I_O) { p0_transpose_item<false>(w_out, DM, DM, WoutT, scr, r, ln); continue; } r -= I_O;
                    p0_transpose_item<false>(w_pq, DM, DM, WqT, scr, r, ln); }
                if (tdx < 8) { const size_t i = (size_t)grp * 64 + tdx * 8;
                    const f32x4 a = *(const GAS f32x4*)(subk + i), b = *(const GAS f32x4*)(subk + i + 4);
                    v4u o; o.x = pk2(a.x, a.y); o.y = pk2(a.z, a.w); o.z = pk2(b.x, b.y); o.w = pk2(b.z, b.w);
                    *(GAS v4u*)(SK + i) = o; }
                VM_WAIT(); __syncthreads();
                continue;
            }
            const int ua = 3 * grp + pos;
            if (ua < 512) {
                const int h = 7 - (ua >> 6), r = ua & 63, b = r >> 5, qb = r & 31;
                const float slope = __builtin_amdgcn_exp2f(-(float)(h + 1));
                const float Df = (2.0f * Sb + 32.0f * 0.6931472f + __logf(2.0f * (1.0f / slope + 1.0f))) / slope;
                const int D = Df > 16384.0f ? 16384 : (int)Df + 1;
                const int qlo = 16 + 256 * qb, qhi = qlo + 255;
                int Tlo = (qlo - D <= 15) ? 0 : (qlo - D - 15 + 63) / 64;
                int Thi = (qhi + D + 48) / 64; if (Thi > 128) Thi = 128;
#pragma unroll 1
                for (int c = 0; c < 2; ++c) att::da_unit((ATT_LAS char*)F.lds, lds0, DP, b, h, c, qb, Tlo, Thi);
                __syncthreads();
                { int tdx = F.tid; asm volatile("" : "+v"(tdx));
                  const int sub = tdx & 7; float lam;
                  { const int ln = tdx & 63; const float a = lq1[ln] * lk1[ln], b2 = lq2[ln] * lk2[ln]; lam = expf(wave_sum(a)) - expf(wave_sum(b2)) + 0.2f; }
#pragma unroll 1
                  for (int rr = tdx >> 3; rr < 256; rr += 64) {
                    const size_t eo = ((size_t)b * SEQ + (size_t)qb * 256 + rr) * 1024 + h * 128 + sub * 16;
                    const bf16* p0 = OC + eo; const bf16* p1 = p0 + (size_t)M * 1024;
                    const v4u a0 = *(const GAS v4u*)p0, a1 = *(const GAS v4u*)(p0 + 8), b0 = *(const GAS v4u*)p1, b1 = *(const GAS v4u*)(p1 + 8);
                    float o[16];
#define CMB(i, A, Bv) o[2 * (i)] = pg8::bf_lo(A) - lam * pg8::bf_lo(Bv); o[2 * (i) + 1] = pg8::bf_hi(A) - lam * pg8::bf_hi(Bv);
                    CMB(0, a0.x, b0.x) CMB(1, a0.y, b0.y) CMB(2, a0.z, b0.z) CMB(3, a0.w, b0.w) CMB(4, a1.x, b1.x) CMB(5, a1.y, b1.y) CMB(6, a1.z, b1.z) CMB(7, a1.w, b1.w)
#undef CMB
                    float ss = 0.f;
#pragma unroll
                    for (int i = 0; i < 16; ++i) ss += o[i] * o[i];
                    ss += __shfl_xor(ss, 1); ss += __shfl_xor(ss, 2); ss += __shfl_xor(ss, 4);
                    const float rs = __builtin_amdgcn_rsqf(ss * (1.0f / 128.0f) + EPS) * 0.8f;
                    f32x4 gv[4];
#pragma unroll
                    for (int i = 0; i < 4; ++i) gv[i] = *(const GAS f32x4*)(g_oda + sub * 16 + 4 * i);
                    v4u w0, w1;
                    w0.x = pk2(o[0] * rs * gv[0][0], o[1] * rs * gv[0][1]); w0.y = pk2(o[2] * rs * gv[0][2], o[3] * rs * gv[0][3]);
                    w0.z = pk2(o[4] * rs * gv[1][0], o[5] * rs * gv[1][1]); w0.w = pk2(o[6] * rs * gv[1][2], o[7] * rs * gv[1][3]);
                    w1.x = pk2(o[8] * rs * gv[2][0], o[9] * rs * gv[2][1]); w1.y = pk2(o[10] * rs * gv[2][2], o[11] * rs * gv[2][3]);
                    w1.z = pk2(o[12] * rs * gv[3][0], o[13] * rs * gv[3][1]); w1.w = pk2(o[14] * rs * gv[3][2], o[15] * rs * gv[3][3]);
                    *(GAS v4u*)(ODA + eo) = w0; *(GAS v4u*)(ODA + eo + 8) = w1;
                  }
                  VM_WAIT(); __syncthreads(); }
            } else {
                const int v = ua - 512, bh = v >> 5;
                att::na_unit((ATT_LAS char*)F.lds, lds0, NP, bh >> 4, bh & 15, v & 31);
            }
        }
        if (BOTH(2)) GRID_BAR();
    }


    if (IN(4)) {
        { pg8::Gemm g{ODA, WbdaT, M, DM, 1024}; pg8::StaticOrder S; S.init(M, DM, F.G, (int)blockIdx.x);
          pg8::EpiGate<0> E{SGDA, nullptr, Y1};
          pg8::gemm_phase<pg8::EpiGate<0>, pg8::StaticOrder, true, true>(F.lds + RING_OFF, g, S, E); }
        VM_WAIT(); __syncthreads();
        { pg8::Gemm g{ONA, WbnaT, M, DM, 1024}; pg8::StaticOrder S; S.init(M, DM, F.G, (int)blockIdx.x);
          pg8::EpiGate<1> E{SGNA, Y1, MIX};
          pg8::gemm_phase<pg8::EpiGate<1>, pg8::StaticOrder, true, true>(F.lds + RING_OFF, g, S, E); }
        if (BOTH(4)) GRID_BAR();
    }

    if (IN(5)) {
        pg8::Gemm g{MIX, WoutT, M, DM, DM}; pg8::StaticOrder S; S.init(M, DM, F.G, (int)blockIdx.x);
        pg8::EpiOut E{x, OUT, H2G, g2, SSP};
        pg8::gemm_phase<pg8::EpiOut, pg8::StaticOrder, true, true>(F.lds + RING_OFF, g, S, E);
        if (BOTH(5)) GRID_BAR();
    }

    if (IN(6)) {
        pg8::Gemm g{H2G, WqT, M, DM, DM}; pg8::StaticOrder S; S.init(M, DM, F.G, (int)blockIdx.x);
        pg8::EpiPQ E{PQ, SSP};
        pg8::gemm_phase<pg8::EpiPQ, pg8::StaticOrder, true, true>(F.lds + RING_OFF, g, S, E);
        if (BOTH(6)) GRID_BAR();
    }

    if (IN(7)) {
#pragma unroll 1
        for (int tile = (int)blockIdx.x; tile < M / PEER_TOK; tile += F.G) peer_retrieve(F, PQ, SK, SELE, SELG, tile);
        if (BOTH(7)) GRID_BAR();
    }
    if (IN(8)) {
        peer_slice_pass<0>(F, U6S, SELE, nullptr, H2G, PART, g2, OUT);
        if (BOTH(8)) GRID_BAR();
    }
    if (IN(9)) {
        for (size_t idx = (size_t)blockIdx.x * (NWAVES * 64) + F.tid; idx < (size_t)M * 32; idx += (size_t)F.G * (NWAVES * 64)) {
            const size_t t = idx >> 5; const int k4 = (int)(idx & 31) * 4;
            f32x4 sum = *(const GAS f32x4*)(PART + t * 128 + k4);
#pragma unroll
            for (int xs = 1; xs < 8; ++xs) sum += *(const GAS f32x4*)(PART + ((size_t)xs * M + t) * 128 + k4);
            const float rstd = pg8::row_rstd(SSP, (int)t);
            const v2u ids = *(const GAS v2u*)(SELE + t * 128 + k4); const f32x4 gt = *(const GAS f32x4*)(SELG + t * 128 + k4);
            const unsigned e[4] = {ids.x & 0xffffu, ids.x >> 16, ids.y & 0xffffu, ids.y >> 16};
            f32x4 w;
#pragma unroll
            for (int c = 0; c < 4; ++c) { const f32x2 sc = *(const GAS f32x2*)(SCL + 2 * e[c]); w[c] = gt[c] * gelu_tanh(sum[c] * (rstd * sc[0])) * sc[1]; }
            *(GAS f32x4*)(PW + t * 128 + k4) = w;
        }
        if (BOTH(9)) GRID_BAR();
    }
    if (IN(10)) {
        peer_slice_pass<1>(F, V6S, SELE, PW, H2G, nullptr, g2, OUT);
    }
#undef IN
#undef BOTH
}

extern "C" void kernel_launch(void* const* d_in, const int* in_sizes, int n_in, void* d_out, int out_size, void* d_ws, size_t ws_size, hipStream_t stream) {
    static int grid = 0;
    if (grid == 0) {
        if (n_in != 22 || in_sizes[0] != M * DM || out_size != M * DM || ws_size < WS_END) { fprintf(stderr, "kernel_launch: unexpected shapes (n_in %d, in0 %d, out %d, ws %zu); nothing launched\n", n_in, n_in > 0 ? in_sizes[0] : -1, out_size, ws_size); grid = -1; return; }
        int dev = 0, cus = 0, per_cu = 0;
        if (hipGetDevice(&dev) != hipSuccess || hipDeviceGetAttribute(&cus, hipDeviceAttributeMultiprocessorCount, dev) != hipSuccess) { grid = -1; return; }
        if (hipFuncSetAttribute((const void*)mk_fwd, hipFuncAttributeMaxDynamicSharedMemorySize, LDS_BYTES) != hipSuccess) { fprintf(stderr, "kernel_launch: hipFuncSetAttribute failed\n"); grid = -1; return; }
        if (hipOccupancyMaxActiveBlocksPerMultiprocessor(&per_cu, (const void*)mk_fwd, NWAVES * 64, LDS_BYTES) != hipSuccess || per_cu < 1)
            fprintf(stderr, "kernel_launch: note: occupancy query reports %d workgroups per CU\n", per_cu);
        (void)hipGetLastError();
        grid = cus;
    }
    if (grid < 0) return;
    if (hipMemsetAsync((char*)d_ws + WS_CTL, 0, CTL_ZERO_BYTES, stream) != hipSuccess) return;
    Args a{};
    for (int i = 0; i < 22; ++i) a.in[i] = (const float*)d_in[i];
    a.out = (float*)d_out; a.ws = (unsigned char*)d_ws;
    if (N_LAUNCHES == 1) { a.ph_lo = 0; a.ph_hi = N_PHASES; a.li = 0; hipLaunchKernelGGL(mk_fwd, dim3(grid), dim3(NWAVES * 64), LDS_BYTES, stream, a); }
    else for (int li = 0; li < N_PHASES; ++li) { a.ph_lo = li; a.ph_hi = li + 1; a.li = li; hipLaunchKernelGGL(mk_fwd, dim3(grid), dim3(NWAVES * 64), LDS_BYTES, stream, a); }
}
```

```cpp
#include <hip/hip_runtime.h>
#include <cstdio>
#include <cstdint>

constexpr int BATCH = 2, SEQ = 8192, DM = 2048, M = BATCH * SEQ, NMETA = 16;
constexpr int INCOLS = 10240;
constexpr float EPS = 1e-6f;
constexpr float QSCALE = 0.125f * 1.4426950408889634f;
constexpr float LOG2E = 1.4426950408889634f;
constexpr float NEGBIG = -1.0e30f;

namespace pg8 {
#define PG8_LAS __attribute__((address_space(3)))
typedef unsigned short bf16_t;
typedef short bf16x8 __attribute__((ext_vector_type(8)));
typedef float f32x4 __attribute__((ext_vector_type(4)));
typedef unsigned u32x4 __attribute__((ext_vector_type(4)));
constexpr int BM = 256, BK = 64, HALF = 128, HTB = HALF * BK * 2  , STAGE_BYTES = 8 * HTB, NXCD = 8, WGM = 8;

__host__ __device__ __forceinline__ int lds_byte(int r, int c) { const int st = (r >> 4) * 2 + (c >> 5), rr = r & 15, cc = c & 31, ob = rr * 64 + cc * 2; return st * 1024 + (ob ^ (((ob >> 9) & 1) << 5)); }
__host__ __device__ __forceinline__ void stage_rc(int b, int& R, int& C) { const int st = b / 1024, sb = b % 1024, swz = sb ^ (((sb >> 9) & 1) << 5); R = (st >> 1) * 16 + swz / 64; C = (st & 1) * 32 + (swz % 64) / 2; }
__host__ __device__ __forceinline__ int perm32(int rho) { const int n = rho >> 4, i = rho & 15; return 8 * (i >> 2) + 4 * n + (i & 3); }

struct Unit { int pm, pn; };
struct Gemm { const bf16_t* A; const bf16_t* Bt; int M, N, K; };

struct StaticOrder {
    int nM, nN, nwg, G, c;
    __host__ __device__ void init(int M, int N, int G_, int c_) { nM = M / BM; nN = N / BM; nwg = nM * nN; G = G_; c = c_; }
    __host__ __device__ bool next(int i, Unit& u) const {
        const long L = (long)i * G + c; if (L >= nwg) return false;
        int wgid = (int)L; { const int q = nwg / NXCD, r = nwg % NXCD, xcd = wgid % NXCD, off = wgid / NXCD; wgid = (xcd < r ? xcd * (q + 1) : r * (q + 1) + (xcd - r) * q) + off; }
        const int nig = WGM * nN, gid = wgid / nig, fm = gid * WGM, gsz = (nM - fm) < WGM ? (nM - fm) : WGM;
        u.pm = fm + ((wgid % nig) % gsz); u.pn = (wgid % nig) / gsz; return true;
    }
    __device__ __forceinline__ void a_ready(const Unit&) const {}
    __device__ __forceinline__ void done(const Unit&) const {}
};


typedef float cvf32x2_t __attribute__((ext_vector_type(2))); typedef __bf16 cvbf16x2_t __attribute__((ext_vector_type(2)));
__device__ __forceinline__ unsigned cvt_pk_bf16(float lo, float hi) { const cvf32x2_t v = {lo, hi}; const cvbf16x2_t b = __builtin_convertvector(v, cvbf16x2_t); return __builtin_bit_cast(unsigned, b); }
__device__ __forceinline__ float bf_lo(unsigned w) { return __builtin_bit_cast(float, w << 16); }
__device__ __forceinline__ float bf_hi(unsigned w) { return __builtin_bit_cast(float, w & 0xffff0000u); }
__device__ __forceinline__ float sigmoidf_(float v) { return __builtin_amdgcn_rcpf(1.0f + __builtin_amdgcn_exp2f(-v * 1.4426950408889634f)); }

struct EpiIn {
    static constexpr bool PERM = true, AFTER_DRAIN = false;
    bf16_t *QDA, *KDA, *VDA, *QNA, *KNA, *VNA, *SGDA, *SGNA;
    const float *gq_da, *gk_da, *gq_na, *gk_na;
    __device__ __forceinline__ void operator()(const f32x4 (&acc)[2][2][4][2], const Unit& u, int wr, int wc, int fr, int fq) const {
        const int pn = u.pn; const int row0 = u.pm * BM + wr * 64 + fr;
        int kind, ct; bf16_t* base; const float* gain = nullptr; float osc = 1.f;
        if (pn < 4)       { kind = 1; base = QDA; ct = pn;      gain = gq_da; osc = QSCALE; }
        else if (pn < 8)  { kind = 1; base = KDA; ct = pn - 4;  gain = gk_da; }
        else if (pn < 12) { kind = 0; base = VDA; ct = pn - 8; }
        else if (pn < 16) { kind = 1; base = QNA; ct = pn - 12; gain = gq_na; osc = QSCALE; }
        else if (pn < 20) { kind = 1; base = KNA; ct = pn - 16; gain = gk_na; }
        else if (pn < 24) { kind = 0; base = VNA; ct = pn - 20; }
        else if (pn < 32) { kind = 2; base = SGDA; ct = pn - 24; }
        else              { kind = 2; base = SGNA; ct = pn - 32; }
        if (kind == 1) {
            f32x4 gv[2][2];
#pragma unroll
            for (int bj = 0; bj < 2; ++bj)
#pragma unroll
                for (int n = 0; n < 2; ++n) gv[bj][n] = *(const f32x4*)(gain + 32 * bj + 8 * fq + 4 * n);
#pragma unroll
            for (int ai = 0; ai < 2; ++ai)
#pragma unroll
                for (int m = 0; m < 4; ++m) {
                    float ss = 0.f;
#pragma unroll
                    for (int bj = 0; bj < 2; ++bj)
#pragma unroll
                        for (int n = 0; n < 2; ++n) { const f32x4 x = acc[ai][bj][m][n]; ss += (x[0] * x[0] + x[1] * x[1]) + (x[2] * x[2] + x[3] * x[3]); }
                    ss += __shfl_xor(ss, 16); ss += __shfl_xor(ss, 32);
                    const float rs = __builtin_amdgcn_rsqf(ss * (1.0f / 64.0f) + EPS) * osc;
                    bf16_t* rowp = base + (size_t)(row0 + ai * HALF + m * 16) * 1024 + ct * 256 + 64 * wc + 8 * fq;
#pragma unroll
                    for (int bj = 0; bj < 2; ++bj) { const f32x4 v0 = acc[ai][bj][m][0] * rs * gv[bj][0], v1 = acc[ai][bj][m][1] * rs * gv[bj][1];
                        u32x4 w; w.x = cvt_pk_bf16(v0[0], v0[1]); w.y = cvt_pk_bf16(v0[2], v0[3]); w.z = cvt_pk_bf16(v1[0], v1[1]); w.w = cvt_pk_bf16(v1[2], v1[3]);
                        *(u32x4*)(rowp + 32 * bj) = w; }
                }
        } else {
            const int ldc = (kind == 2) ? 2048 : 1024;
#pragma unroll
            for (int ai = 0; ai < 2; ++ai)
#pragma unroll
                for (int m = 0; m < 4; ++m) {
                    bf16_t* rowp = base + (size_t)(row0 + ai * HALF + m * 16) * ldc + ct * 256 + 32 * wc + 8 * fq;
#pragma unroll
                    for (int bj = 0; bj < 2; ++bj) { f32x4 v0 = acc[ai][bj][m][0], v1 = acc[ai][bj][m][1];
                        if (kind == 2) {
#pragma unroll
                            for (int j = 0; j < 4; ++j) { v0[j] = sigmoidf_(v0[j]); v1[j] = sigmoidf_(v1[j]); } }
                        u32x4 w; w.x = cvt_pk_bf16(v0[0], v0[1]); w.y = cvt_pk_bf16(v0[2], v0[3]); w.z = cvt_pk_bf16(v1[0], v1[1]); w.w = cvt_pk_bf16(v1[2], v1[3]);
                        *(u32x4*)(rowp + bj * HALF) = w; }
                }
        }
    }
};

template <int MODE> struct EpiGate {
    static constexpr bool PERM = true, AFTER_DRAIN = false;
    const bf16_t* G; const bf16_t* P; bf16_t* Y;
    __device__ __forceinline__ void operator()(const f32x4 (&acc)[2][2][4][2], const Unit& u, int wr, int wc, int fr, int fq) const {
        const int row0 = u.pm * BM + wr * 64 + fr, col0 = u.pn * BM + wc * 32 + 8 * fq;
#pragma unroll
        for (int ai = 0; ai < 2; ++ai)
#pragma unroll
            for (int m = 0; m < 4; ++m) { const size_t off = (size_t)(row0 + ai * HALF + m * 16) * 2048 + col0;
#pragma unroll
                for (int bj = 0; bj < 2; ++bj) { const u32x4 g = *(const u32x4*)(G + off + bj * HALF); const f32x4 a0 = acc[ai][bj][m][0], a1 = acc[ai][bj][m][1];
                    float r[8] = { bf_lo(g.x) * a0[0], bf_hi(g.x) * a0[1], bf_lo(g.y) * a0[2], bf_hi(g.y) * a0[3], bf_lo(g.z) * a1[0], bf_hi(g.z) * a1[1], bf_lo(g.w) * a1[2], bf_hi(g.w) * a1[3] };
                    if (MODE == 1) { const u32x4 p = *(const u32x4*)(P + off + bj * HALF);
                        r[0] += bf_lo(p.x); r[1] += bf_hi(p.x); r[2] += bf_lo(p.y); r[3] += bf_hi(p.y); r[4] += bf_lo(p.z); r[5] += bf_hi(p.z); r[6] += bf_lo(p.w); r[7] += bf_hi(p.w); }
                    u32x4 w; w.x = cvt_pk_bf16(r[0], r[1]); w.y = cvt_pk_bf16(r[2], r[3]); w.z = cvt_pk_bf16(r[4], r[5]); w.w = cvt_pk_bf16(r[6], r[7]);
                    *(u32x4*)(Y + off + bj * HALF) = w; } }
    }
};

struct EpiOut {
    static constexpr bool PERM = false, AFTER_DRAIN = false;
    const float* X; float* OUT; bf16_t* H2G; const float* g2; float* SSP;
    __device__ __forceinline__ void operator()(const f32x4 (&acc)[2][2][4][2], const Unit& u, int wr, int wc, int fr, int fq) const {
        const int row0 = u.pm * BM + wr * 64 + fr, col0 = u.pn * BM + wc * 32 + 4 * fq;
        f32x4 gv[2][2];
#pragma unroll
        for (int bj = 0; bj < 2; ++bj)
#pragma unroll
            for (int n = 0; n < 2; ++n) gv[bj][n] = *(const f32x4*)(g2 + col0 + bj * HALF + n * 16);
#pragma unroll
        for (int ai = 0; ai < 2; ++ai)
#pragma unroll
            for (int m = 0; m < 4; ++m) { const int row = row0 + ai * HALF + m * 16; const size_t off = (size_t)row * 2048 + col0; float ss = 0.f;
#pragma unroll
                for (int bj = 0; bj < 2; ++bj)
#pragma unroll
                    for (int n = 0; n < 2; ++n) { const f32x4 h = *(const f32x4*)(X + off + bj * HALF + n * 16) + acc[ai][bj][m][n];
                        ss += (h[0] * h[0] + h[1] * h[1]) + (h[2] * h[2] + h[3] * h[3]);
                        const f32x4 hg = h * gv[bj][n]; unsigned long long w = (unsigned long long)cvt_pk_bf16(hg[0], hg[1]) | ((unsigned long long)cvt_pk_bf16(hg[2], hg[3]) << 32);
                        *(unsigned long long*)(H2G + off + bj * HALF + n * 16) = w; }
                ss += __shfl_xor(ss, 16); ss += __shfl_xor(ss, 32);
                if (fq == 0) SSP[(size_t)row * 32 + u.pn * 4 + wc] = ss; }
    }
};

__device__ __forceinline__ float row_rstd(const float* SSP, int row) {
    const f32x4* p = (const f32x4*)(SSP + (size_t)row * 32); float s = 0.f;
#pragma unroll
    for (int i = 0; i < 8; ++i) { const f32x4 v = p[i]; s += (v[0] + v[1]) + (v[2] + v[3]); }
    return __builtin_amdgcn_rsqf(s * (1.0f / 2048.0f) + EPS);
}
struct EpiPQ {
    static constexpr bool PERM = true, AFTER_DRAIN = false;
    bf16_t* PQ; const float* SSP;
    __device__ __forceinline__ void operator()(const f32x4 (&acc)[2][2][4][2], const Unit& u, int wr, int wc, int fr, int fq) const {
        const int row0 = u.pm * BM + wr * 64 + fr, col0 = u.pn * BM + wc * 32 + 8 * fq;
#pragma unroll
        for (int ai = 0; ai < 2; ++ai)
#pragma unroll
            for (int m = 0; m < 4; ++m) { const int row = row0 + ai * HALF + m * 16; const float rs = row_rstd(SSP, row);
                bf16_t* rowp = PQ + (size_t)row * 2048 + col0;
#pragma unroll
                for (int bj = 0; bj < 2; ++bj) { const f32x4 v0 = acc[ai][bj][m][0] * rs, v1 = acc[ai][bj][m][1] * rs;
                    u32x4 w; w.x = cvt_pk_bf16(v0[0], v0[1]); w.y = cvt_pk_bf16(v0[2], v0[3]); w.z = cvt_pk_bf16(v1[0], v1[1]); w.w = cvt_pk_bf16(v1[2], v1[3]);
                    *(u32x4*)(rowp + bj * HALF) = w; } }
    }
};

template <class Epi, class Sched, bool ALIGN_EPI = false, bool SP2 = false>
__device__ __forceinline__ void gemm_phase(PG8_LAS unsigned char* lds, const Gemm g, const Sched& S, const Epi& E) {
    const int tid = threadIdx.x, wid = __builtin_amdgcn_readfirstlane(tid >> 6), lane = tid & 63, wr = wid >> 2, wc = wid & 3, fr = lane & 15, fq = lane >> 4;
    const int K = g.K, nt = K / BK;
    unsigned voffA[2], voffB[2];
#pragma unroll
    for (int i = 0; i < 2; ++i) { int R, C; stage_rc(tid * 16 + i * 8192, R, C); const int Rb = Epi::PERM ? ((R & ~31) + perm32(R & 31)) : R;
        voffA[i] = (unsigned)(R * K + C) * 2u; voffB[i] = (unsigned)(Rb * K + C) * 2u; }
    const size_t kstep = (size_t)(BK * 2);
    const size_t hstep = (size_t)HALF * K * 2;
    const size_t tstep = 2 * hstep;
    const unsigned ldsw = (unsigned)wid * 1024u;
    const int aoff = lds_byte(wr * 64 + fr, fq * 8), boff = lds_byte(wc * 32 + fr, fq * 8);
#define PG8_SA(b, h) (((b) * 2 + (h)) * HTB)
#define PG8_SB(b, h) ((4 + (b) * 2 + (h)) * HTB)
#define PG8_STAGE(bufoff, gbase, voff) do { _Pragma("unroll") for (int _i = 0; _i < 2; ++_i) \
        __builtin_amdgcn_global_load_lds((const unsigned*)((const char*)(gbase) + (voff)[_i]), (PG8_LAS unsigned*)(lds + (bufoff) + ldsw + _i * 8192), 16, 0, 0); } while (0)
#define PG8_LDA(dst, b, h) do { _Pragma("unroll") for (int m = 0; m < 4; ++m) _Pragma("unroll") for (int k = 0; k < 2; ++k) dst[m][k] = *(const PG8_LAS bf16x8*)(lds + PG8_SA(b, h) + aoff + m * 2048 + k * 1024); } while (0)
#define PG8_LDB(dst, b, h) do { _Pragma("unroll") for (int n = 0; n < 2; ++n) _Pragma("unroll") for (int k = 0; k < 2; ++k) dst[n][k] = *(const PG8_LAS bf16x8*)(lds + PG8_SB(b, h) + boff + n * 2048 + k * 1024); } while (0)
#define PG8_MMA(ai, bj, At, Bt) do { __builtin_amdgcn_s_setprio(1); _Pragma("unroll") for (int m = 0; m < 4; ++m) _Pragma("unroll") for (int n = 0; n < 2; ++n) _Pragma("unroll") for (int k = 0; k < 2; ++k) \
        acc[ai][bj][m][n] = __builtin_amdgcn_mfma_f32_16x16x32_bf16(Bt[n][k], At[m][k], acc[ai][bj][m][n], 0, 0, 0); __builtin_amdgcn_s_setprio(0); } while (0)
#define PG8_WAIT_V(n) asm volatile("s_waitcnt vmcnt(" #n ")" ::: "memory")
#define PG8_WAIT_L(n) asm volatile("s_waitcnt lgkmcnt(" #n ")" ::: "memory")
#define PG8_BAR __builtin_amdgcn_s_barrier()
#define PG8_SCHED __builtin_amdgcn_sched_barrier(0)
    Unit cur, nxt; int ui = 0;
    if (!S.next(0, cur)) return;
    f32x4 acc[2][2][4][2];
#pragma unroll
    for (int a = 0; a < 2; ++a)
#pragma unroll
        for (int b = 0; b < 2; ++b)
#pragma unroll
            for (int m = 0; m < 4; ++m)
#pragma unroll
                for (int n = 0; n < 2; ++n) acc[a][b][m][n] = (f32x4){0.f, 0.f, 0.f, 0.f};
    bf16x8 At[4][2], B0[2][2], B1[2][2];
    const char* cA = (const char*)g.A + (size_t)cur.pm * tstep; const char* cB = (const char*)g.Bt + (size_t)cur.pn * tstep;
    S.a_ready(cur);
    if constexpr (SP2) {
        PG8_STAGE(PG8_SB(0, 0), cB, voffB); PG8_STAGE(PG8_SB(0, 1), cB + hstep, voffB); PG8_STAGE(PG8_SA(0, 0), cA, voffA); PG8_STAGE(PG8_SA(0, 1), cA + hstep, voffA);
        if (wr == 1) PG8_BAR;
        PG8_WAIT_V(2); PG8_BAR;
        PG8_STAGE(PG8_SB(1, 0), cB + kstep, voffB); PG8_STAGE(PG8_SA(1, 0), cA + kstep, voffA); PG8_STAGE(PG8_SB(1, 1), cB + hstep + kstep, voffB);
        PG8_WAIT_V(6); PG8_BAR;
    } else {
        PG8_STAGE(PG8_SB(0, 0), cB, voffB); PG8_STAGE(PG8_SA(0, 0), cA, voffA); PG8_STAGE(PG8_SB(0, 1), cB + hstep, voffB); PG8_STAGE(PG8_SA(0, 1), cA + hstep, voffA);
        if (wr == 1) PG8_BAR;
        PG8_WAIT_V(4); PG8_BAR;
        PG8_STAGE(PG8_SB(1, 0), cB + kstep, voffB); PG8_STAGE(PG8_SA(1, 0), cA + kstep, voffA); PG8_STAGE(PG8_SB(1, 1), cB + hstep + kstep, voffB);
        PG8_WAIT_V(6); PG8_BAR;
    }
    for (;;) {
        const bool has_next = S.next(ui + 1, nxt);
        const char* nA = has_next ? (const char*)g.A + (size_t)nxt.pm * tstep : cA; const char* nB = has_next ? (const char*)g.Bt + (size_t)nxt.pn * tstep : cB;
        for (int t = 0; t < nt; t += 2) {
            const bool last = (t == nt - 2);
            const char* a1 = cA + (size_t)(t + 1) * kstep;
            const char* a2 = last ? nA : cA + (size_t)(t + 2) * kstep; const char* b2 = last ? nB : cB + (size_t)(t + 2) * kstep;
            const char* a3 = a2 + kstep; const char* b3 = b2 + kstep;
            if (last && has_next) S.a_ready(nxt);
            if constexpr (SP2) {
            PG8_LDB(B0, 0, 0); PG8_LDB(B1, 0, 1); PG8_SCHED; PG8_LDA(At, 0, 0); PG8_STAGE(PG8_SA(1, 1), a1 + hstep, voffA);
            PG8_WAIT_V(8); PG8_WAIT_L(0); PG8_BAR; PG8_MMA(0, 0, At, B0); PG8_MMA(0, 1, At, B1); PG8_BAR; PG8_SCHED;
            PG8_LDA(At, 0, 1); PG8_STAGE(PG8_SB(0, 0), b2, voffB); PG8_STAGE(PG8_SB(0, 1), b2 + hstep, voffB); PG8_STAGE(PG8_SA(0, 0), a2, voffA);
            PG8_WAIT_V(8); PG8_WAIT_L(0); PG8_BAR; PG8_MMA(1, 0, At, B0); PG8_MMA(1, 1, At, B1); PG8_BAR; PG8_SCHED;
            PG8_LDB(B0, 1, 0); PG8_LDB(B1, 1, 1); PG8_SCHED; PG8_LDA(At, 1, 0); PG8_STAGE(PG8_SA(0, 1), a2 + hstep, voffA);
            PG8_WAIT_V(8); PG8_WAIT_L(0); PG8_BAR; PG8_MMA(0, 0, At, B0); PG8_MMA(0, 1, At, B1); PG8_BAR; PG8_SCHED;
            PG8_LDA(At, 1, 1); PG8_STAGE(PG8_SB(1, 0), b3, voffB); PG8_STAGE(PG8_SB(1, 1), b3 + hstep, voffB); PG8_STAGE(PG8_SA(1, 0), a3, voffA);
            PG8_WAIT_V(8); PG8_WAIT_L(0); PG8_BAR; PG8_MMA(1, 0, At, B0); PG8_MMA(1, 1, At, B1); PG8_BAR; PG8_SCHED;
            } else {
            PG8_LDB(B0, 0, 0); PG8_SCHED; PG8_LDA(At, 0, 0); PG8_STAGE(PG8_SA(1, 1), a1 + hstep, voffA);
            PG8_WAIT_L(8); PG8_BAR; PG8_WAIT_L(0); PG8_MMA(0, 0, At, B0); PG8_BAR; PG8_SCHED;
            PG8_LDB(B1, 0, 1); PG8_STAGE(PG8_SB(0, 0), b2, voffB);
            PG8_BAR; PG8_WAIT_L(0); PG8_MMA(0, 1, At, B1); PG8_BAR;
            PG8_LDA(At, 0, 1); PG8_STAGE(PG8_SA(0, 0), a2, voffA);
            PG8_BAR; PG8_WAIT_L(0); PG8_MMA(1, 0, At, B0); PG8_BAR; PG8_SCHED;
            PG8_STAGE(PG8_SB(0, 1), b2 + hstep, voffB);
            PG8_WAIT_V(6); PG8_BAR; PG8_MMA(1, 1, At, B1); PG8_BAR;
            PG8_LDB(B0, 1, 0); PG8_SCHED; PG8_LDA(At, 1, 0); PG8_STAGE(PG8_SA(0, 1), a2 + hstep, voffA);
            PG8_WAIT_L(8); PG8_BAR; PG8_WAIT_L(0); PG8_MMA(0, 0, At, B0); PG8_BAR; PG8_SCHED;
            PG8_LDB(B1, 1, 1); PG8_STAGE(PG8_SB(1, 0), b3, voffB);
            PG8_BAR; PG8_WAIT_L(0); PG8_MMA(0, 1, At, B1); PG8_BAR;
            PG8_LDA(At, 1, 1); PG8_STAGE(PG8_SA(1, 0), a3, voffA);
            PG8_BAR; PG8_WAIT_L(0); PG8_MMA(1, 0, At, B0); PG8_BAR; PG8_SCHED;
            PG8_STAGE(PG8_SB(1, 1), b3 + hstep, voffB);
            PG8_WAIT_V(6); PG8_BAR; PG8_MMA(1, 1, At, B1); PG8_BAR;
            }
        }
        if constexpr (ALIGN_EPI) { if (wr == 0) PG8_BAR; }
        if constexpr (!Epi::AFTER_DRAIN) { E(acc, cur, wr, wc, fr, fq); S.done(cur); }
        if (!has_next) break;
#pragma unroll
        for (int a = 0; a < 2; ++a)
#pragma unroll
            for (int b = 0; b < 2; ++b)
#pragma unroll
                for (int m = 0; m < 4; ++m)
#pragma unroll
                    for (int n = 0; n < 2; ++n) acc[a][b][m][n] = (f32x4){0.f, 0.f, 0.f, 0.f};
        cur = nxt; cA = nA; cB = nB; ++ui;
        if constexpr (ALIGN_EPI) { if (wr == 1) PG8_BAR; }
    }
    PG8_WAIT_V(0);
    if constexpr (!ALIGN_EPI) { if (wr == 0) PG8_BAR; }
    PG8_BAR;
    if constexpr (Epi::AFTER_DRAIN) { E.fused(acc, cur, wr, wc, fr, fq, lds, wid, lane); S.done(cur); }
#undef PG8_SA
#undef PG8_SB
#undef PG8_STAGE
#undef PG8_LDA
#undef PG8_LDB
#undef PG8_MMA
#undef PG8_WAIT_V
#undef PG8_WAIT_L
#undef PG8_BAR
#undef PG8_SCHED
}
}

namespace att {
#define ATT_LAS __attribute__((address_space(3)))
typedef unsigned short bf16_t;
typedef short bf16x8 __attribute__((ext_vector_type(8)));
typedef short s16x4 __attribute__((ext_vector_type(4)));
typedef float f32x16 __attribute__((ext_vector_type(16)));
typedef float f32x4 __attribute__((ext_vector_type(4)));
typedef unsigned u32x4 __attribute__((ext_vector_type(4)));
typedef unsigned u32x2 __attribute__((ext_vector_type(2)));
typedef ATT_LAS const char* lds_cptr;
constexpr int NSLOT = 4, KSLOT = 8192, VSLOT = 16384;
constexpr int LDS_K = 0, LDS_V = NSLOT * KSLOT, LDS_TBL = LDS_V + NSLOT * VSLOT, TBL_FLOATS = 640, LDS_BYTES = LDS_TBL + TBL_FLOATS * 4;

__device__ __forceinline__ void glds16(const void* gsrc, unsigned lds_dst) { unsigned keep;
    asm volatile("s_mov_b32 %0, m0\n\ts_mov_b32 m0, %2\n\ts_nop 0\n\tglobal_load_lds_dwordx4 %1, off\n\ts_mov_b32 m0, %0" : "=&s"(keep) : "v"(gsrc), "s"(lds_dst) : "memory"); }
#define ATT_WAIT_BAR(N) asm volatile("s_waitcnt vmcnt(" #N ") lgkmcnt(0)\n\ts_barrier" ::: "memory")
__device__ __forceinline__ unsigned cvtpk(float lo, float hi) { return pg8::cvt_pk_bf16(lo, hi); }
typedef short v4i16_t __attribute__((ext_vector_type(4)));
__device__ __forceinline__ s16x4 vtr(lds_cptr p) { return __builtin_bit_cast(s16x4, __builtin_amdgcn_ds_read_tr16_b64_v4i16((ATT_LAS v4i16_t*)p)); }
__device__ __forceinline__ int crow(int r, int hi) { return (r & 3) + 8 * (r >> 2) + 4 * hi; }

template <int KIND>
__device__ __forceinline__ void na_tile(lds_cptr Ks, lds_cptr Vl, const bf16x8 (&qr)[4], f32x16 (&oT)[2], float& mref, float& lsum, const f32x16& ma0, const f32x16& ma1, const ATT_LAS float* tb, int r32, int hi) {
#define NA_V0(r) (KIND == 0 || (KIND == 1 && (r) >= 12))
#define NA_V1(r) ((KIND == 0 && (r) < 4) || KIND == 1 || (KIND == 2 && (r) >= 8))
    f32x16 p0, p1;
#pragma unroll
    for (int r = 0; r < 16; ++r) { p0[r] = (KIND == 2) ? 0.f : ma0[r] - mref; p1[r] = (KIND == 2) ? -mref : ma1[r] - mref; }
    const lds_cptr kb = Ks + hi * 1024 + r32 * 16;
#pragma unroll
    for (int d0 = 0; d0 < 4; ++d0) {
        if (KIND != 2) { const bf16x8 b0 = *(const ATT_LAS bf16x8*)(kb + d0 * 2048); p0 = __builtin_amdgcn_mfma_f32_32x32x16_bf16(b0, qr[d0], p0, 0, 0, 0); }
        { const bf16x8 b1 = *(const ATT_LAS bf16x8*)(kb + d0 * 2048 + 512); p1 = __builtin_amdgcn_mfma_f32_32x32x16_bf16(b1, qr[d0], p1, 0, 0, 0); }
    }
    if (KIND != 2) {
#pragma unroll
        for (int r = 0; r < 16; ++r) { const int cr = (r & 3) + 8 * (r >> 2); if (NA_V0(r)) p0[r] += tb[cr]; if (NA_V1(r)) p1[r] += tb[cr + 32]; }
    }
    float tm = -3.0e38f;
#pragma unroll
    for (int r = 0; r < 16; ++r) { if (NA_V0(r)) tm = __builtin_fmaxf(tm, p0[r]); if (NA_V1(r)) tm = __builtin_fmaxf(tm, p1[r]); }
    { const auto rr = __builtin_amdgcn_permlane32_swap(__builtin_bit_cast(unsigned, tm), __builtin_bit_cast(unsigned, tm), false, false);
      tm = __builtin_fmaxf(__builtin_bit_cast(float, rr[0]), __builtin_bit_cast(float, rr[1])); }
    if (__any(tm > 8.0f)) {
        const float d = __builtin_fmaxf(tm, 0.f), alpha = __builtin_amdgcn_exp2f(-d);
        mref += d; lsum *= alpha;
#pragma unroll
        for (int r = 0; r < 16; ++r) { p0[r] -= d; p1[r] -= d; }
#pragma unroll
        for (int db = 0; db < 2; ++db)
#pragma unroll
            for (int r = 0; r < 16; ++r) oT[db][r] *= alpha;
    }
    float s0 = 0.f, s1 = 0.f;
#pragma unroll
    for (int r = 0; r < 16; ++r) {
        if (NA_V0(r)) { p0[r] = __builtin_amdgcn_exp2f(p0[r]); s0 += p0[r]; } else p0[r] = 0.f;
        if (NA_V1(r)) { p1[r] = __builtin_amdgcn_exp2f(p1[r]); s1 += p1[r]; } else p1[r] = 0.f; }
    lsum += s0 + s1;
    bf16x8 pw[4];
    { u32x4 w;
      w.x = cvtpk(p0[0], p0[1]); w.y = cvtpk(p0[2], p0[3]); w.z = cvtpk(p0[4], p0[5]); w.w = cvtpk(p0[6], p0[7]); pw[0] = __builtin_bit_cast(bf16x8, w);
      w.x = cvtpk(p0[8], p0[9]); w.y = cvtpk(p0[10], p0[11]); w.z = cvtpk(p0[12], p0[13]); w.w = cvtpk(p0[14], p0[15]); pw[1] = __builtin_bit_cast(bf16x8, w);
      w.x = cvtpk(p1[0], p1[1]); w.y = cvtpk(p1[2], p1[3]); w.z = cvtpk(p1[4], p1[5]); w.w = cvtpk(p1[6], p1[7]); pw[2] = __builtin_bit_cast(bf16x8, w);
      w.x = cvtpk(p1[8], p1[9]); w.y = cvtpk(p1[10], p1[11]); w.z = cvtpk(p1[12], p1[13]); w.w = cvtpk(p1[14], p1[15]); pw[3] = __builtin_bit_cast(bf16x8, w); }
#pragma unroll
    for (int db = 0; db < 2; ++db)
#pragma unroll
        for (int ks = 0; ks < 4; ++ks) {
            const bool live = (ks == 0) ? NA_V0(0) : (ks == 1) ? NA_V0(15) : (ks == 2) ? NA_V1(0) : NA_V1(15);
            if (live) {
                const lds_cptr vp = Vl + db * 4096 + ks * 1024;
                const s16x4 lo = vtr(vp), h4 = vtr(vp + 512);
                const bf16x8 vf = (bf16x8){lo[0], lo[1], lo[2], lo[3], h4[0], h4[1], h4[2], h4[3]};
                oT[db] = __builtin_amdgcn_mfma_f32_32x32x16_bf16(vf, pw[ks], oT[db], 0, 0, 0);
            }
        }
#undef NA_V0
#undef NA_V1
}

__device__ __forceinline__ void store_block_w16(bf16_t* rowp, const f32x16& o, float sc, int hi) {
#pragma unroll
    for (int g = 0; g < 4; g += 2) {
        unsigned ax = cvtpk(o[4 * g] * sc, o[4 * g + 1] * sc), ay = cvtpk(o[4 * g + 2] * sc, o[4 * g + 3] * sc);
        unsigned bx = cvtpk(o[4 * g + 4] * sc, o[4 * g + 5] * sc), by = cvtpk(o[4 * g + 6] * sc, o[4 * g + 7] * sc);
        { const auto r = __builtin_amdgcn_permlane32_swap(ax, bx, false, false); ax = r[0]; bx = r[1]; }
        { const auto r = __builtin_amdgcn_permlane32_swap(ay, by, false, false); ay = r[0]; by = r[1]; }
        *(u32x4*)(rowp + 8 * (g + hi)) = (u32x4){ax, ay, bx, by};
    }
}

struct DAParams { const bf16_t *Q, *K, *V, *Kmeta, *Vmeta; bf16_t* OC; float mref; };

template <bool GEN, bool META, bool DO_PV>
__device__ __forceinline__ void da_step(lds_cptr Ks, lds_cptr Vp, const bf16x8 (&qr)[4], bf16x8 qx, bf16x8 kx0, bf16x8 kx1, f32x16 (&oT)[4], float& lsum, bf16x8 (&pw)[4],
                                        float qrel4, float sl2, float mref, int r32, int hi) {
#define SBAR() __builtin_amdgcn_sched_barrier(0)
#define DA_VFRAG(dst, i) do { const lds_cptr vp_ = Vp + ((i) >> 2) * 4096 + ((i) & 3) * 1024; const s16x4 lo_ = vtr(vp_), h4_ = vtr(vp_ + 512); \
        dst = (bf16x8){lo_[0], lo_[1], lo_[2], lo_[3], h4_[0], h4_[1], h4_[2], h4_[3]}; } while (0)
    constexpr int PF = 5, NR = 6;
    bf16x8 vf[NR];
    if (DO_PV) {
#pragma unroll
        for (int i = 0; i < PF; ++i) DA_VFRAG(vf[i], i);
    }
    f32x16 p0, p1;
    if (GEN) {
#pragma unroll
        for (int r = 0; r < 16; ++r) { p0[r] = -mref; p1[r] = -mref; }
    } else {
        f32x16 z;
#pragma unroll
        for (int r = 0; r < 16; ++r) z[r] = 0.f;
        p0 = __builtin_amdgcn_mfma_f32_32x32x16_bf16(kx0, qx, z, 0, 0, 0);
        p1 = __builtin_amdgcn_mfma_f32_32x32x16_bf16(kx1, qx, z, 0, 0, 0);
    }
    const lds_cptr kb = Ks + hi * 1024 + r32 * 16;
#pragma unroll
    for (int d0 = 0; d0 < 4; ++d0) {
        const bf16x8 b0 = *(const ATT_LAS bf16x8*)(kb + d0 * 2048), b1 = *(const ATT_LAS bf16x8*)(kb + d0 * 2048 + 512);
        p0 = __builtin_amdgcn_mfma_f32_32x32x16_bf16(b0, qr[d0], p0, 0, 0, 0);
        p1 = __builtin_amdgcn_mfma_f32_32x32x16_bf16(b1, qr[d0], p1, 0, 0, 0);
    }
    if (GEN) {
#pragma unroll
        for (int r = 0; r < 16; ++r) { const float c = (float)((r & 3) + 8 * (r >> 2));
            p0[r] = __builtin_fmaf(-sl2, __builtin_fabsf(qrel4 - c), p0[r]);
            p1[r] = __builtin_fmaf(-sl2, __builtin_fabsf(qrel4 - (c + 32.0f)), p1[r]); }
    }
    if (META) {
#pragma unroll
        for (int r = 0; r < 16; ++r) p0[r] = NEGBIG;
#pragma unroll
        for (int r = 0; r < 8; ++r) p1[r] = NEGBIG;
    }
    if (DO_PV) {
        float s0 = 0.f, s1 = 0.f;
        SBAR();
#pragma unroll
        for (int i = 0; i < 16; ++i) {
            if (i + PF < 16) DA_VFRAG(vf[(i + PF) % NR], i + PF);
            SBAR();
            oT[i >> 2] = __builtin_amdgcn_mfma_f32_32x32x16_bf16(vf[i % NR], pw[i & 3], oT[i >> 2], 0, 0, 0);
            SBAR();
            if (i < 8) { p0[2 * i] = __builtin_amdgcn_exp2f(p0[2 * i]); p0[2 * i + 1] = __builtin_amdgcn_exp2f(p0[2 * i + 1]); s0 += p0[2 * i]; s1 += p0[2 * i + 1]; }
            else { p1[2 * i - 16] = __builtin_amdgcn_exp2f(p1[2 * i - 16]); p1[2 * i - 15] = __builtin_amdgcn_exp2f(p1[2 * i - 15]); s0 += p1[2 * i - 16]; s1 += p1[2 * i - 15]; }
            asm volatile("" : "+v"(s0), "+v"(s1));
            SBAR();
        }
        lsum += s0 + s1;
#pragma unroll
        for (int ks = 0; ks < 4; ++ks) {
            { u32x4 w;
              if (ks == 0) { w.x = cvtpk(p0[0], p0[1]); w.y = cvtpk(p0[2], p0[3]); w.z = cvtpk(p0[4], p0[5]); w.w = cvtpk(p0[6], p0[7]); }
              else if (ks == 1) { w.x = cvtpk(p0[8], p0[9]); w.y = cvtpk(p0[10], p0[11]); w.z = cvtpk(p0[12], p0[13]); w.w = cvtpk(p0[14], p0[15]); }
              else if (ks == 2) { w.x = cvtpk(p1[0], p1[1]); w.y = cvtpk(p1[2], p1[3]); w.z = cvtpk(p1[4], p1[5]); w.w = cvtpk(p1[6], p1[7]); }
              else { w.x = cvtpk(p1[8], p1[9]); w.y = cvtpk(p1[10], p1[11]); w.z = cvtpk(p1[12], p1[13]); w.w = cvtpk(p1[14], p1[15]); }
              pw[ks] = __builtin_bit_cast(bf16x8, w); }
        }
    } else {
        float s0 = 0.f, s1 = 0.f;
#pragma unroll
        for (int r = 0; r < 16; ++r) { p0[r] = __builtin_amdgcn_exp2f(p0[r]); p1[r] = __builtin_amdgcn_exp2f(p1[r]); s0 += p0[r]; s1 += p1[r]; }
        lsum += s0 + s1;
        u32x4 w;
        w.x = cvtpk(p0[0], p0[1]); w.y = cvtpk(p0[2], p0[3]); w.z = cvtpk(p0[4], p0[5]); w.w = cvtpk(p0[6], p0[7]); pw[0] = __builtin_bit_cast(bf16x8, w);
        w.x = cvtpk(p0[8], p0[9]); w.y = cvtpk(p0[10], p0[11]); w.z = cvtpk(p0[12], p0[13]); w.w = cvtpk(p0[14], p0[15]); pw[1] = __builtin_bit_cast(bf16x8, w);
        w.x = cvtpk(p1[0], p1[1]); w.y = cvtpk(p1[2], p1[3]); w.z = cvtpk(p1[4], p1[5]); w.w = cvtpk(p1[6], p1[7]); pw[2] = __builtin_bit_cast(bf16x8, w);
        w.x = cvtpk(p1[8], p1[9]); w.y = cvtpk(p1[10], p1[11]); w.z = cvtpk(p1[12], p1[13]); w.w = cvtpk(p1[14], p1[15]); pw[3] = __builtin_bit_cast(bf16x8, w);
    }
#undef DA_VFRAG
#undef SBAR
}

__device__ __forceinline__ void da_unit(ATT_LAS char* lds, unsigned lds0, const DAParams& P, int b, int h, int c, int qb, int Tlo, int Thi) {
    int tid = threadIdx.x; asm volatile("" : "+v"(tid));
    const int lane = tid & 63, r32 = lane & 31, hi = lane >> 5; const int wid = __builtin_amdgcn_readfirstlane(tid >> 6);
    const int qi0 = qb * 256 + wid * 32, qi = qi0 + r32;
    const size_t mrow = (size_t)b * SEQ + qi;
    const float slp2 = __builtin_amdgcn_exp2f(-(float)(h + 1)) * LOG2E, mref = P.mref;
    const lds_cptr ldsc = (lds_cptr)lds;
    const lds_cptr vl0 = ldsc + LDS_V + ((lane >> 4) & 1) * 32 + (lane & 3) * 8 + (4 * hi + ((lane & 15) >> 2)) * 64;
    const bf16_t* Qp = P.Q + mrow * 1024 + h * 128 + c * 64;
    bf16x8 qr[4];
#pragma unroll
    for (int d0 = 0; d0 < 4; ++d0) qr[d0] = *(const bf16x8*)(Qp + d0 * 16 + hi * 8);
    asm volatile("s_waitcnt vmcnt(0)" : "+v"(qr[0]), "+v"(qr[1]), "+v"(qr[2]), "+v"(qr[3]) :: "memory");
    const int kcol = h * 128 + c * 64, vcol = h * 128;
    const bf16_t* kreal = P.K + (size_t)b * SEQ * 1024 + kcol + (size_t)lane * 1024 + wid * 8;
    const bf16_t* kmeta = P.Kmeta + kcol + (size_t)lane * 1024 + wid * 8;
    const int vro = (16 * (wid & 3) + (lane >> 2)) * 1024 + (lane & 3) * 8;
    const bf16_t* vreal = P.V + (size_t)b * SEQ * 1024 + vcol + vro + 32 * (wid >> 2);
    const bf16_t* vmeta = P.Vmeta + vcol + vro + 32 * (wid >> 2);
#define DA_DMA(T, slot) do { const int T_ = (T); const unsigned so_ = (unsigned)(slot); \
    const bf16_t* ks_ = T_ == 0 ? kmeta : kreal + (size_t)(T_ - 1) * 65536; const bf16_t* vs_ = T_ == 0 ? vmeta : vreal + (size_t)(T_ - 1) * 65536; \
    glds16(ks_, (unsigned)__builtin_amdgcn_readfirstlane(lds0 + LDS_K + so_ * KSLOT + wid * 1024)); \
    glds16(vs_, (unsigned)__builtin_amdgcn_readfirstlane(lds0 + LDS_V + so_ * VSLOT + wid * 1024)); \
    glds16(vs_ + 64, (unsigned)__builtin_amdgcn_readfirstlane(lds0 + LDS_V + so_ * VSLOT + (wid + 8) * 1024)); } while (0)
#define DA_MODE(T) ((qi0 - 64 * ((T) - 1) - 4 >= 59) ? 0 : ((qi0 - 64 * ((T) - 1) + 31 <= 0) ? 1 : 2))
    bf16x8 kx0, kx1;
    { const unsigned m = hi ? 0u : 0xffffffffu;
      const u32x4 a0 = (u32x4){cvtpk((float)r32, (float)r32) & m, 0x3f803f80u & m, 0u, 0u}, a1 = (u32x4){cvtpk((float)(r32 + 32), (float)(r32 + 32)) & m, 0x3f803f80u & m, 0u, 0u};
      kx0 = __builtin_bit_cast(bf16x8, a0); kx1 = __builtin_bit_cast(bf16x8, a1); }
    const float sg_hi = __builtin_bit_cast(float, cvtpk(slp2, 0.f) << 16), sg_lo = slp2 - sg_hi;
#define DA_QX(dst, T, md) do { const float sg_ = ((md) == 0) ? 1.0f : -1.0f; const float lb_ = -sg_ * slp2 * (float)(qi - 64 * ((T) - 1)) - mref; \
        const float lbh_ = __builtin_bit_cast(float, cvtpk(lb_, 0.f) << 16); const unsigned m_ = hi ? 0u : 0xffffffffu; \
        const u32x4 q_ = (u32x4){cvtpk(sg_ * sg_hi, sg_ * sg_lo) & m_, cvtpk(lbh_, lb_ - lbh_) & m_, 0u, 0u}; dst = __builtin_bit_cast(bf16x8, q_); } while (0)
    f32x16 oT[4]; float lsum = 0.f;
#pragma unroll
    for (int r = 0; r < 16; ++r) { oT[0][r] = 0.f; oT[1][r] = 0.f; oT[2][r] = 0.f; oT[3][r] = 0.f; }
    bf16x8 pw[4];
    DA_DMA(Tlo, 0); DA_DMA(Tlo + 1, 1);
    ATT_WAIT_BAR(3);
    DA_DMA(Tlo + 2, 2);
    { const int md = DA_MODE(Tlo); bf16x8 qx; DA_QX(qx, Tlo, md); const float q4 = (float)(qi - 64 * (Tlo - 1) - 4 * hi);
      if (Tlo == 0) da_step<false, true, false>(ldsc + LDS_K, vl0, qr, qx, kx0, kx1, oT, lsum, pw, q4, slp2, mref, r32, hi);
      else if (md == 2) da_step<true, false, false>(ldsc + LDS_K, vl0, qr, qx, kx0, kx1, oT, lsum, pw, q4, slp2, mref, r32, hi);
      else da_step<false, false, false>(ldsc + LDS_K, vl0, qr, qx, kx0, kx1, oT, lsum, pw, q4, slp2, mref, r32, hi); }
    int sk = 1, sv = 0, sd = 3;
#pragma unroll 1
    for (int T = Tlo + 1; T <= Thi; ++T) {
        if (T + 1 <= Thi) ATT_WAIT_BAR(3); else ATT_WAIT_BAR(0);
        if (T + 2 <= Thi) DA_DMA(T + 2, sd);
        const int md = DA_MODE(T); bf16x8 qx; DA_QX(qx, T, md); const float q4 = (float)(qi - 64 * (T - 1) - 4 * hi);
        if (md == 2) da_step<true, false, true>(ldsc + LDS_K + sk * KSLOT, vl0 + sv * VSLOT, qr, qx, kx0, kx1, oT, lsum, pw, q4, slp2, mref, r32, hi);
        else da_step<false, false, true>(ldsc + LDS_K + sk * KSLOT, vl0 + sv * VSLOT, qr, qx, kx0, kx1, oT, lsum, pw, q4, slp2, mref, r32, hi);
        sk = (sk + 1) & 3; sv = (sv + 1) & 3; sd = (sd + 1) & 3;
    }
    {
        const lds_cptr Vp = vl0 + sv * VSLOT;
#pragma unroll
        for (int db = 0; db < 4; ++db)
#pragma unroll
            for (int ks = 0; ks < 4; ++ks) { const lds_cptr vp = Vp + db * 4096 + ks * 1024; const s16x4 lo = vtr(vp), h4 = vtr(vp + 512);
                const bf16x8 vf = (bf16x8){lo[0], lo[1], lo[2], lo[3], h4[0], h4[1], h4[2], h4[3]}; oT[db] = __builtin_amdgcn_mfma_f32_32x32x16_bf16(vf, pw[ks], oT[db], 0, 0, 0); }
    }
    ATT_WAIT_BAR(0);
#undef DA_DMA
#undef DA_QX
#undef DA_MODE
    const float inv = __builtin_amdgcn_rcpf(lsum + __shfl_xor(lsum, 32));
    bf16_t* Op = P.OC + (size_t)c * M * 1024 + mrow * 1024 + h * 128;
#pragma unroll
    for (int db = 0; db < 4; ++db) store_block_w16(Op + 32 * db, oT[db], inv, hi);
    asm volatile("s_waitcnt vmcnt(0)" ::: "memory");
}

struct NAParams { const bf16_t *Q, *K, *V, *Kmeta, *Vmeta; bf16_t* O; const float* rpb; };

__device__ __forceinline__ void na_unit(ATT_LAS char* lds, unsigned lds0, const NAParams& P, int b, int h, int rblk) {
    const int tid = threadIdx.x, lane = tid & 63, r32 = lane & 31, hi = lane >> 5; const int wid = __builtin_amdgcn_readfirstlane(tid >> 6);
    const lds_cptr ldsc = (lds_cptr)lds;
    ATT_LAS float* tbl = (ATT_LAS float*)(lds + LDS_TBL);
    { int tq = tid; asm volatile("" : "+v"(tq));
      if (tq < 465) tbl[64 + tq] = P.rpb[h * 465 + tq] * LOG2E; }
    const int rq = 4 * rblk + (wid >> 1), c = 32 * (wid & 1) + r32;
    int cs = c - 8; cs = cs < 0 ? 0 : (cs > 48 ? 48 : cs);
    int r0 = rq - 4; r0 = r0 < 0 ? 0 : (r0 > 120 ? 120 : r0);
    int jlo = 4 * rblk - 4; jlo = jlo < 0 ? 0 : (jlo > 120 ? 120 : jlo);
    int jhi = 4 * rblk - 1; jhi = (jhi < 0 ? 0 : (jhi > 120 ? 120 : jhi)) + 7;
    const int NT = jhi - jlo + 2;
    const size_t mrow = (size_t)b * SEQ + 64 * rq + c;
    const bf16_t* Qp = P.Q + mrow * 1024 + h * 64;
    bf16x8 qr[4];
#pragma unroll
    for (int d0 = 0; d0 < 4; ++d0) qr[d0] = *(const bf16x8*)(Qp + d0 * 16 + hi * 8);
    asm volatile("s_waitcnt vmcnt(0)" : "+v"(qr[0]), "+v"(qr[1]), "+v"(qr[2]), "+v"(qr[3]) :: "memory");
    const int kcol = h * 64;
    const bf16_t* kreal = P.K + ((size_t)b * SEQ + (size_t)jlo * 64) * 1024 + kcol + (size_t)lane * 1024 + wid * 8;
    const bf16_t* kmeta = P.Kmeta + kcol + (size_t)lane * 1024 + wid * 8;
    const int vro = (16 * (wid & 3) + (lane >> 2)) * 1024 + (lane & 3) * 8 + 32 * (wid >> 2);
    const bf16_t* vreal = P.V + ((size_t)b * SEQ + (size_t)jlo * 64) * 1024 + kcol + vro;
    const bf16_t* vmeta = P.Vmeta + kcol + vro;
    const lds_cptr vl0 = ldsc + LDS_V + ((lane >> 4) & 1) * 32 + (lane & 3) * 8 + (4 * hi + ((lane & 15) >> 2)) * 64;
#define NA_DMA(t, slot) do { const int t_ = (t); const unsigned so_ = (unsigned)(slot); \
    const bf16_t* ks_ = t_ == NT - 1 ? kmeta : kreal + (size_t)t_ * 65536; const bf16_t* vs_ = t_ == NT - 1 ? vmeta : vreal + (size_t)t_ * 65536; \
    glds16(ks_, (unsigned)__builtin_amdgcn_readfirstlane(lds0 + LDS_K + so_ * KSLOT + wid * 1024)); \
    glds16(vs_, (unsigned)__builtin_amdgcn_readfirstlane(lds0 + LDS_V + so_ * VSLOT + wid * 1024)); } while (0)
    f32x16 oT[2];
#pragma unroll
    for (int db = 0; db < 2; ++db)
#pragma unroll
        for (int r = 0; r < 16; ++r) oT[db][r] = 0.f;
    float mref = 0.f, lsum = 0.f;
    f32x16 ma0, ma1;
#pragma unroll
    for (int r = 0; r < 16; ++r) { const int cr = (r & 3) + 8 * (r >> 2) + 4 * hi - cs;
        ma0[r] = ((unsigned)cr < 16u) ? 0.f : NEGBIG; ma1[r] = ((unsigned)(cr + 32) < 16u) ? 0.f : NEGBIG; }
    NA_DMA(0, 0); NA_DMA(1, 1);
    int sl = 0, sl2 = 2;
#pragma unroll 1
    for (int t = 0; t < NT; ++t) {
        if (t + 1 < NT) ATT_WAIT_BAR(2); else ATT_WAIT_BAR(0);
        if (t + 2 < NT) NA_DMA(t + 2, sl2);
        const int jr = jlo + t; const bool meta = (t == NT - 1);
        if (meta || (jr >= r0 && jr < r0 + 8)) {
            const ATT_LAS float* tb = tbl + 64 + (jr - rq + 7) * 31 + 4 * hi - c + 15;
            if (meta) na_tile<2>(ldsc + LDS_K + sl * KSLOT, vl0 + sl * VSLOT, qr, oT, mref, lsum, ma0, ma1, tb, r32, hi);
            else if (wid & 1) na_tile<1>(ldsc + LDS_K + sl * KSLOT, vl0 + sl * VSLOT, qr, oT, mref, lsum, ma0, ma1, tb, r32, hi);
            else na_tile<0>(ldsc + LDS_K + sl * KSLOT, vl0 + sl * VSLOT, qr, oT, mref, lsum, ma0, ma1, tb, r32, hi);
        }
        sl = (sl == 2) ? 0 : sl + 1; sl2 = (sl2 == 2) ? 0 : sl2 + 1;
    }
    ATT_WAIT_BAR(0);
#undef NA_DMA
    const float l = lsum + __shfl_xor(lsum, 32), inv = __builtin_amdgcn_rcpf(l);
    bf16_t* Op = P.O + mrow * 1024 + h * 64;
#pragma unroll
    for (int db = 0; db < 2; ++db) store_block_w16(Op + 32 * db, oT[db], inv, hi);
    asm volatile("s_waitcnt vmcnt(0)" ::: "memory");
}
}


constexpr int NWAVES = 8;
#ifndef MK_N_LAUNCHES
#define MK_N_LAUNCHES 1
#endif
constexpr int N_LAUNCHES = MK_N_LAUNCHES, N_PHASES = 11;

constexpr size_t MiB = 1u << 20;
constexpr size_t WS_CTL = 0, CTL_ZERO_BYTES = 1 * MiB;
constexpr size_t WS_WIN_T = 2 * MiB;
constexpr size_t WS_WBDA_T = 42 * MiB, WS_WBNA_T = 46 * MiB;
constexpr size_t WS_WOUT_T = 50 * MiB, WS_WQ_T = 58 * MiB;
constexpr size_t WS_SK = 66 * MiB;
constexpr size_t WS_XNM = 66 * MiB + 64 * 1024;
constexpr size_t WS_METAKV = 66 * MiB + 128 * 1024;
constexpr size_t METAKV_BLK = 64 * 1024 * 2;
constexpr size_t WS_SSP = 67 * MiB;
constexpr size_t WS_UV6 = 70 * MiB;
constexpr size_t WS_SCL = 118 * MiB;
constexpr size_t WS_U6S = 120 * MiB, WS_V6S = 144 * MiB;
constexpr size_t WS_SELE = 168 * MiB;
constexpr size_t WS_SELG = 172 * MiB;
constexpr size_t WS_PW = 180 * MiB;
constexpr size_t WS_PART = 198 * MiB;
constexpr size_t WS_XN = 198 * MiB;
constexpr size_t WS_OC = WS_XN;
constexpr size_t WS_ODA = WS_XN, WS_ONA = 454 * MiB;
constexpr size_t WS_QDA = 262 * MiB, WS_KDA = 294 * MiB, WS_VDA = 326 * MiB, WS_QNA = 358 * MiB, WS_KNA = 390 * MiB, WS_VNA = 422 * MiB;
constexpr size_t WS_END = 486 * MiB;
constexpr size_t WS_Y1 = WS_QDA;
constexpr size_t WS_MIX = WS_VDA;
constexpr size_t WS_H2G = WS_KNA;
constexpr size_t WS_PQ = WS_QDA;
constexpr int CW_BAR = 4096, CW_QUEUE = 8192;

constexpr int RING_OFF = 0, RING_BYTES = 131072;
constexpr int LDSCTL_OFF = 143360, MISC_OFF = LDSCTL_OFF + 320;
constexpr int LDS_BYTES = 147456;
static_assert(MISC_OFF + 128 <= LDS_BYTES && att::LDS_BYTES <= LDSCTL_OFF && RING_BYTES <= LDSCTL_OFF, "LDS map");

#define GAS __attribute__((address_space(1)))
#define LAS __attribute__((address_space(3)))
typedef unsigned short bf16;
typedef unsigned v4u __attribute__((ext_vector_type(4)));
typedef unsigned v2u __attribute__((ext_vector_type(2)));
typedef float f32x4 __attribute__((ext_vector_type(4)));
typedef float f32x2 __attribute__((ext_vector_type(2)));
typedef float f32x16 __attribute__((ext_vector_type(16)));
typedef short bf16x8 __attribute__((ext_vector_type(8)));
typedef __bf16 bf16x2_t __attribute__((ext_vector_type(2)));
typedef GAS unsigned gu32;
#define RLX_AGENT __ATOMIC_RELAXED, __HIP_MEMORY_SCOPE_AGENT
#define LDS_WAIT() asm volatile("s_waitcnt lgkmcnt(0)" ::: "memory")
#define VM_WAIT() asm volatile("s_waitcnt vmcnt(0)" ::: "memory")
__device__ __forceinline__ unsigned f2bf(float f) { unsigned u = __builtin_bit_cast(unsigned, f); return (u + 0x7fffu + ((u >> 16) & 1u)) >> 16; }
__device__ __forceinline__ unsigned pk2(float lo, float hi) { return f2bf(lo) | (f2bf(hi) << 16); }

#define XB_TMO      128
#define XB_XCNT(j)  (256  + 64 * (j))
#define XB_XSUB(j)  (1280 + 64 * (j))
#define XB_XGEN(j)  (2304 + 64 * (j))
#define XB_TOP      3328
#define XB_TOPGEN   3392
#define XCD_BAR_WORDS 3456
#define XB_SPIN_CAP (1u << 22)

__device__ __forceinline__ unsigned xb_ld(unsigned* p)              { return __hip_atomic_load(p, __ATOMIC_RELAXED, __HIP_MEMORY_SCOPE_AGENT); }
__device__ __forceinline__ unsigned xb_add(unsigned* p, unsigned v) { return __hip_atomic_fetch_add(p, v, __ATOMIC_RELAXED, __HIP_MEMORY_SCOPE_AGENT); }
__device__ __forceinline__ unsigned xb_xcc_id() { return (unsigned)__builtin_amdgcn_s_getreg((3 << 11) | 20) & 0xFu; }
#define XB_SPIN(cond, bar) do { unsigned _sp = 0; while (cond) { __builtin_amdgcn_s_sleep(1); \
    if ((++_sp & 255u) == 0u) { if (xb_ld(&(bar)[XB_TMO])) break; if (_sp > XB_SPIN_CAP) { atomicAdd(&(bar)[XB_TMO], 1u); break; } } } } while (0)

struct XcdBarrier { unsigned* bar; unsigned x; volatile LAS unsigned* st; };

__device__ __forceinline__ XcdBarrier xcd_barrier_post(unsigned* bar, volatile LAS unsigned* st) {
    XcdBarrier b; b.bar = bar; b.x = xb_xcc_id(); b.st = st;
    if (threadIdx.x == 0) (void)xb_add(&bar[XB_XCNT(b.x)], 1u);
    return b;
}
__device__ __forceinline__ void xcd_barrier_complete(unsigned* bar, unsigned x, unsigned& nloc, unsigned& nx) {
    const unsigned G = gridDim.x * gridDim.y * gridDim.z;
    unsigned sum, cnt, mine, sp = 0u;
    for (;;) {
        sum = 0u; cnt = 0u; mine = 0u;
#pragma unroll
        for (unsigned j = 0; j < 16; ++j) { const unsigned c = xb_ld(&bar[XB_XCNT(j)]); sum += c; cnt += (c > 0u) ? 1u : 0u; mine = (j == x) ? c : mine; }
        if (sum == G) break;
        __builtin_amdgcn_s_sleep(1);
        if ((++sp & 255u) == 0u) { if (xb_ld(&bar[XB_TMO])) break; if (sp > XB_SPIN_CAP) { atomicAdd(&bar[XB_TMO], 1u); break; } }
    }
    nloc = mine > 0u ? mine : 1u; nx = cnt > 0u ? cnt : 1u;
}
__device__ __forceinline__ void xcd_barrier(const XcdBarrier& b) {
    asm volatile("s_waitcnt vmcnt(0)" ::: "memory");
    __syncthreads();
    if (threadIdx.x == 0) {
        unsigned* bar = b.bar;
        __builtin_amdgcn_s_waitcnt(0);
        unsigned nloc = b.st[0], nx = b.st[1];
        if (nloc == 0u) { xcd_barrier_complete(bar, b.x, nloc, nx); b.st[0] = nloc; b.st[1] = nx; }
        const unsigned old = xb_add(&bar[XB_XSUB(b.x)], 1u);
        const unsigned gen = old / nloc;
        if (old + 1u == (gen + 1u) * nloc) {
            __builtin_amdgcn_fence(__ATOMIC_RELEASE, "agent");
            asm volatile("s_waitcnt vmcnt(0)" ::: "memory");
            const unsigned og = xb_add(&bar[XB_TOP], 1u);
            const unsigned tg = og / nx;
            if (og + 1u == (tg + 1u) * nx) xb_add(&bar[XB_TOPGEN], 1u);
            else XB_SPIN(xb_ld(&bar[XB_TOPGEN]) == tg, bar);
            __builtin_amdgcn_fence(__ATOMIC_ACQUIRE, "agent");
            xb_add(&bar[XB_XGEN(b.x)], 1u);
            asm volatile("s_waitcnt vmcnt(0)" ::: "memory");
        } else {
            XB_SPIN(xb_ld(&bar[XB_XGEN(b.x)]) == gen, bar);
            __builtin_amdgcn_fence(__ATOMIC_ACQUIRE, "agent");
            asm volatile("s_waitcnt vmcnt(0)" ::: "memory");
        }
    }
    __syncthreads();
}

struct Frame {
    LAS unsigned char* lds;
    volatile LAS unsigned* MISC;
    int tid, lane, wave;
    int vcu, G;
};

__device__ __forceinline__ float wave_sum(float v) {
#pragma unroll
    for (int o = 1; o < 64; o <<= 1) v += __shfl_xor(v, o);
    return v;
}
__device__ __forceinline__ float wave_sum_dpp(float v) {
#define DPPF(x, ctrl, rmask, bc) __builtin_bit_cast(float, __builtin_amdgcn_update_dpp(0, __builtin_bit_cast(int, (x)), (ctrl), (rmask), 0xf, (bc)))
    v += DPPF(v, 0x111, 0xf, true); v += DPPF(v, 0x112, 0xf, true); v += DPPF(v, 0x114, 0xf, true); v += DPPF(v, 0x118, 0xf, true);
    v += DPPF(v, 0x142, 0xa, false);
    v += DPPF(v, 0x143, 0xc, false);
#undef DPPF
    return __builtin_bit_cast(float, __builtin_amdgcn_readlane(__builtin_bit_cast(int, v), 63));
}
__device__ __forceinline__ int win_row_of_col(int c) {
    const int pn = c >> 8, cc = c & 255;
    const bool normtile = (pn < 8) || (pn >= 12 && pn < 20);
    if (normtile) return (pn << 8) + 128 * ((cc >> 5) & 1) + 32 * (cc >> 6) + (cc & 31);
    return c;
}
template <bool PERMUTE>
__device__ __forceinline__ void p0_transpose_item(const float* W, int K, int N, bf16* WT, LAS float* scr, int item, int lane) {
    const int nblk = N / 32, kb = item / nblk, nb = item % nblk, k0 = 64 * kb, n0 = 32 * nb;
    const int r0 = PERMUTE ? win_row_of_col(n0) : n0;
#pragma unroll 8
    for (int i = 0; i < 32; ++i) { const int kk = 2 * i + (lane >> 5); scr[kk * 33 + (lane & 31)] = W[(size_t)(k0 + kk) * N + n0 + (lane & 31)]; }
    LDS_WAIT(); asm volatile("" ::: "memory");
    const int c = lane & 7;
#pragma unroll
    for (int j = 0; j < 4; ++j) { const int n = (lane >> 3) + 8 * j; const LAS float* s = scr + (8 * c) * 33 + n;
        v4u o; o.x = pk2(s[0 * 33], s[1 * 33]); o.y = pk2(s[2 * 33], s[3 * 33]); o.z = pk2(s[4 * 33], s[5 * 33]); o.w = pk2(s[6 * 33], s[7 * 33]);
        *(GAS v4u*)(WT + (size_t)(r0 + n) * K + k0 + 8 * c) = o; }
    LDS_WAIT(); asm volatile("" ::: "memory");
}
__device__ __forceinline__ void rms_row_to_bf16(const float* xrow, const float* g, bf16* orow, int lane) {
    const GAS f32x4* xr = (const GAS f32x4*)xrow + lane; const GAS f32x4* gr = (const GAS f32x4*)g + lane;
    f32x4 v[8]; float s = 0.f;
#pragma unroll
    for (int j = 0; j < 8; ++j) { v[j] = xr[64 * j]; s += (v[j].x * v[j].x + v[j].y * v[j].y) + (v[j].z * v[j].z + v[j].w * v[j].w); }
    const float rstd = __builtin_amdgcn_rsqf(wave_sum(s) * (1.f / DM) + EPS);
    GAS unsigned long long* o8 = (GAS unsigned long long*)orow + lane;
#pragma unroll
    for (int j = 0; j < 8; ++j) { const f32x4 gg = gr[64 * j];
        o8[64 * j] = (unsigned long long)pk2(v[j].x * rstd * gg.x, v[j].y * rstd * gg.y) | ((unsigned long long)pk2(v[j].z * rstd * gg.z, v[j].w * rstd * gg.w) << 32); }
}

typedef float f32x16v __attribute__((ext_vector_type(16)));
typedef float f32x32v __attribute__((ext_vector_type(32)));
typedef unsigned v6u __attribute__((ext_vector_type(6)));
__device__ __forceinline__ void fp6_row(const float* src, unsigned char* rec, float* scl, int lane) {
    f32x4 v[8]; float am = 0.f;
#pragma unroll
    for (int q = 0; q < 8; ++q) { v[q] = *(const GAS f32x4*)(src + 32 * lane + 4 * q);
        am = __builtin_fmaxf(am, __builtin_fmaxf(__builtin_fmaxf(__builtin_fabsf(v[q].x), __builtin_fabsf(v[q].y)), __builtin_fmaxf(__builtin_fabsf(v[q].z), __builtin_fabsf(v[q].w)))); }
#pragma unroll
    for (int o = 1; o < 64; o <<= 1) am = __builtin_fmaxf(am, __shfl_xor(am, o));
    am = __builtin_fmaxf(am, 1.0e-30f);
    const float sc = 7.5f / am;
    f32x16v lo, hi;
#pragma unroll
    for (int q = 0; q < 8; ++q) { lo[2 * q] = v[q].x * sc; hi[2 * q] = v[q].y * sc; lo[2 * q + 1] = v[q].z * sc; hi[2 * q + 1] = v[q].w * sc; }
    const v6u p = __builtin_amdgcn_cvt_scalef32_2xpk16_fp6_f32(lo, hi, 1.0f);
    *(GAS v4u*)(rec + lane * 16) = (v4u){p[0], p[1], p[2], p[3]};
    *(GAS v2u*)(rec + 1024 + lane * 8) = (v2u){p[4], p[5]};
    if (lane == 0) *scl = am * (1.0f / 7.5f);
}
__device__ __forceinline__ void fp6_row_sliced(const float* src, unsigned char* tab, int e, float* scl, int lane) {
    f32x4 v[8]; float am = 0.f;
#pragma unroll
    for (int q = 0; q < 8; ++q) { v[q] = *(const GAS f32x4*)(src + 32 * lane + 4 * q);
        am = __builtin_fmaxf(am, __builtin_fmaxf(__builtin_fmaxf(__builtin_fabsf(v[q].x), __builtin_fabsf(v[q].y)), __builtin_fmaxf(__builtin_fabsf(v[q].z), __builtin_fabsf(v[q].w)))); }
#pragma unroll
    for (int o = 1; o < 64; o <<= 1) am = __builtin_fmaxf(am, __shfl_xor(am, o));
    am = __builtin_fmaxf(am, 1.0e-30f);
    const float sc = 7.5f / am;
    f32x16v lo, hi;
#pragma unroll
    for (int q = 0; q < 8; ++q) { lo[2 * q] = v[q].x * sc; hi[2 * q] = v[q].y * sc; lo[2 * q + 1] = v[q].z * sc; hi[2 * q + 1] = v[q].w * sc; }
    const v6u p = __builtin_amdgcn_cvt_scalef32_2xpk16_fp6_f32(lo, hi, 1.0f);
    unsigned char* sl = tab + (size_t)(lane >> 3) * (16384 * 192);
    *(GAS v4u*)(sl + (size_t)e * 128 + (lane & 7) * 16) = (v4u){p[0], p[1], p[2], p[3]};
    *(GAS v2u*)(sl + 16384 * 128 + (size_t)e * 64 + (lane & 7) * 8) = (v2u){p[4], p[5]};
    if (lane == 0) *scl = am * (1.0f / 7.5f);
}
__device__ __forceinline__ void meta_proj(Frame& F, const bf16* XNM, const bf16* WinT, bf16* metakv, const float* gk_da, const float* gk_na, int j) {
    const int s = j >> 4, gi = j & 15;
    const int cbase = (s == 0) ? 1024 : (s == 1) ? 2048 : (s == 2) ? 4096 : 5120;
    const int c0 = cbase + 64 * gi;
    const int l15 = F.lane & 15, kq = F.lane >> 4, w = F.wave;
    f32x4 acc[4];
#pragma unroll
    for (int t = 0; t < 4; ++t) acc[t] = (f32x4){0.f, 0.f, 0.f, 0.f};
    const bf16* ap = XNM + (size_t)l15 * 2048 + 256 * w + 8 * kq;
    const bf16* bp[4];
#pragma unroll
    for (int t = 0; t < 4; ++t) bp[t] = WinT + (size_t)win_row_of_col(c0 + 16 * t + l15) * 2048 + 256 * w + 8 * kq;
#pragma unroll
    for (int ks = 0; ks < 8; ++ks) { const bf16x8 a = *(const GAS bf16x8*)(ap + 32 * ks);
#pragma unroll
        for (int t = 0; t < 4; ++t) { const bf16x8 b = *(const GAS bf16x8*)(bp[t] + 32 * ks); acc[t] = __builtin_amdgcn_mfma_f32_16x16x32_bf16(a, b, acc[t], 0, 0, 0); } }
    LAS float* part = (LAS float*)(F.lds + RING_OFF);
    LAS float* res = part + 8 * 16 * 64;
#pragma unroll
    for (int t = 0; t < 4; ++t)
#pragma unroll
        for (int r = 0; r < 4; ++r) part[(w * 16 + 4 * kq + r) * 64 + 16 * t + l15] = acc[t][r];
    __syncthreads();
#pragma unroll
    for (int q = 0; q < 2; ++q) { const int o = F.tid * 2 + q; float v = 0.f;
#pragma unroll
        for (int ww = 0; ww < 8; ++ww) v += part[ww * 1024 + o];
        res[o] = v; }
    __syncthreads();
    { const int token = 2 * w + (F.lane >> 5), cc = 2 * (F.lane & 31);
      float v0 = res[token * 64 + cc], v1 = res[token * 64 + cc + 1];
      if (s == 0 || s == 2) { float ss = v0 * v0 + v1 * v1;
#pragma unroll
          for (int o = 1; o < 32; o <<= 1) ss += __shfl_xor(ss, o);
          const float rs = __builtin_amdgcn_rsqf(ss * (1.0f / 64.0f) + EPS); const float* g = (s == 0) ? gk_da : gk_na;
          v0 *= rs * g[cc]; v1 *= rs * g[cc + 1]; }
      bf16* dst = metakv + (size_t)s * (64 * 1024) + (size_t)(48 + token) * 1024 + 64 * gi + cc;
      *(GAS unsigned*)dst = pk2(v0, v1); }
    __syncthreads();
}

__device__ __forceinline__ int f2ord(float f) { const int i = __builtin_bit_cast(int, f); return i ^ ((i >> 31) & 0x7fffffff); }
__device__ __forceinline__ float ord2f(int i) { return __builtin_bit_cast(float, i ^ ((i >> 31) & 0x7fffffff)); }
#define TOPK_INS(L, x) do { int v_ = (x); _Pragma("unroll") for (int i_ = 0; i_ < 16; ++i_) { const int t_ = max(L[i_], v_); v_ = min(L[i_], v_); L[i_] = t_; } } while (0)
__device__ __forceinline__ float gelu_tanh(float a) {
    const float z = 0.7978845608028654f * (a + 0.044715f * a * a * a);
    const float e = __builtin_amdgcn_exp2f(z * (2.0f * LOG2E));
    const float th = 1.0f - 2.0f * __builtin_amdgcn_rcpf(e + 1.0f);
    return 0.5f * a * (1.0f + th);
}
constexpr int PEER_TOK = 32;
constexpr int PL_SELE = 0, PL_SELG = 8192, PL_SET = 24576, PL_IDX = 2 * PL_SET;

#define CE_DESC(a, b) do { const int hi_ = max((a), (b)); const int lo_ = min((a), (b)); (a) = hi_; (b) = lo_; } while (0)
__device__ __forceinline__ void sort16_desc(int (&v)[16]) {
#pragma unroll
    for (int k = 2; k <= 16; k <<= 1)
#pragma unroll
        for (int j = k >> 1; j > 0; j >>= 1)
#pragma unroll
            for (int i = 0; i < 16; ++i) { const int l = i ^ j; if (l > i) { if ((i & k) == 0) CE_DESC(v[i], v[l]); else CE_DESC(v[l], v[i]); } }
}
__device__ __forceinline__ void merge16_desc(int (&a)[16], const int (&b)[16]) {
#pragma unroll
    for (int i = 0; i < 16; ++i) a[i] = max(a[i], b[15 - i]);
#pragma unroll
    for (int j = 8; j > 0; j >>= 1)
#pragma unroll
        for (int i = 0; i < 16; ++i) { const int l = i ^ j; if (l > i) CE_DESC(a[i], a[l]); }
}
__device__ __forceinline__ void peer_retrieve(Frame& F, const bf16* PQ, const bf16* SK, unsigned short* SELE, float* SELG, int tile) {
    const int t0 = tile * PEER_TOK, lane = F.lane, r32 = lane & 31, hi = lane >> 5, h = F.wave;
    int L0[16], L1[16];
    int hi4 = 4 * hi; asm volatile("" : "+v"(hi4));
#pragma unroll
    for (int p = 0; p < 2; ++p) {
        f32x16 acc[4];
#pragma unroll
        for (int rt = 0; rt < 4; ++rt)
#pragma unroll
            for (int r = 0; r < 16; ++r) acc[rt][r] = 0.f;
        const bf16* qp = PQ + (size_t)(t0 + r32) * 2048 + h * 256 + p * 128 + hi * 8;
        const bf16* skp = SK + (size_t)p * 16384 + (size_t)r32 * 128 + hi * 8;
        asm volatile("" : "+v"(qp), "+v"(skp));
#pragma unroll
        for (int ks = 0; ks < 8; ++ks) { const bf16x8 bq = *(const GAS bf16x8*)(qp + 16 * ks);
#pragma unroll
            for (int rt = 0; rt < 4; ++rt) { const bf16x8 a = *(const GAS bf16x8*)(skp + rt * 4096 + 16 * ks); acc[rt] = __builtin_amdgcn_mfma_f32_32x32x16_bf16(a, bq, acc[rt], 0, 0, 0); } }
        int L[16];
        {
            int G1[16], G2[16], G3[16];
#pragma unroll
            for (int r = 0; r < 16; ++r) {
                L[r] = ((f2ord(acc[0][r]) & ~127) | hi4) | (0 + (r & 3) + 8 * (r >> 2)); G1[r] = ((f2ord(acc[1][r]) & ~127) | hi4) | (32 + (r & 3) + 8 * (r >> 2));
                G2[r] = ((f2ord(acc[2][r]) & ~127) | hi4) | (64 + (r & 3) + 8 * (r >> 2)); G3[r] = ((f2ord(acc[3][r]) & ~127) | hi4) | (96 + (r & 3) + 8 * (r >> 2)); }
            sort16_desc(L); sort16_desc(G1); merge16_desc(L, G1);
            sort16_desc(G2); sort16_desc(G3); merge16_desc(G2, G3);
            merge16_desc(L, G2);
        }
        int O[16];
#pragma unroll
        for (int i = 0; i < 16; ++i) O[i] = __shfl_xor(L[i], 32);
        merge16_desc(L, O);
#pragma unroll
        for (int i = 0; i < 16; ++i) { if (p == 0) L0[i] = L[i]; else L1[i] = L[i]; }
    }
    int C[16];
#define CKEY(i_, j_) ((f2ord(ord2f(L0[i_] & ~127) + ord2f(L1[j_] & ~127)) & ~255) | ((i_) << 4) | (15 - (j_)))
    {
#pragma unroll
        for (int j = 0; j < 16; ++j) C[j] = CKEY(0, j);
#pragma unroll
        for (int j = 8; j < 16; ++j) C[j] = max(C[j], CKEY(1, 15 - j));
#pragma unroll
        for (int jj = 8; jj > 0; jj >>= 1)
#pragma unroll
            for (int i = 0; i < 16; ++i) { const int l = i ^ jj; if (l > i) CE_DESC(C[i], C[l]); }
        int X[16] = {CKEY(2, 0), CKEY(2, 1), CKEY(2, 2), CKEY(2, 3), CKEY(2, 4), CKEY(3, 0), CKEY(3, 1), CKEY(3, 2), CKEY(3, 3), CKEY(4, 0), CKEY(4, 1), CKEY(4, 2), CKEY(5, 0), CKEY(5, 1), CKEY(6, 0), CKEY(6, 1)};
        sort16_desc(X); merge16_desc(C, X);
        int Y[16] = {CKEY(7, 0), CKEY(7, 1), CKEY(8, 0), CKEY(9, 0), CKEY(10, 0), CKEY(11, 0), CKEY(12, 0), CKEY(13, 0), CKEY(14, 0), CKEY(15, 0),
                     (int)0x80000000, (int)0x80000000, (int)0x80000000, (int)0x80000000, (int)0x80000000, (int)0x80000000};
        sort16_desc(Y); merge16_desc(C, Y);
    }
#undef CKEY
    LAS unsigned* ix = (LAS unsigned*)(F.lds + PL_IDX + F.tid * 32);
#pragma unroll
    for (int q = 0; q < 4; ++q) {
        ix[q] = (unsigned)(L0[4 * q] & 127) | ((unsigned)(L0[4 * q + 1] & 127) << 8) | ((unsigned)(L0[4 * q + 2] & 127) << 16) | ((unsigned)(L0[4 * q + 3] & 127) << 24);
        ix[4 + q] = (unsigned)(L1[4 * q] & 127) | ((unsigned)(L1[4 * q + 1] & 127) << 8) | ((unsigned)(L1[4 * q + 2] & 127) << 16) | ((unsigned)(L1[4 * q + 3] & 127) << 24); }
    const LAS unsigned char* ixb = (const LAS unsigned char*)ix;
    float sc[16]; float sum = 0.f;
#pragma unroll
    for (int k = 0; k < 16; ++k) sc[k] = ord2f(C[k] & ~255);
    const float mx = sc[0];
#pragma unroll
    for (int k = 0; k < 16; ++k) { sc[k] = __builtin_amdgcn_exp2f((sc[k] - mx) * LOG2E); sum += sc[k]; }
    const float rsum = 1.0f / sum;
    if (hi == 0) {
        unsigned ew[8];
#pragma unroll
        for (int k = 0; k < 16; ++k) { const int ij = C[k] & 255; const unsigned e = (unsigned)ixb[ij >> 4] * 128u + (unsigned)ixb[16 + (15 - (ij & 15))];
            if (k & 1) ew[k >> 1] |= e << 16; else ew[k >> 1] = e; }
        GAS v4u* ep = (GAS v4u*)(SELE + (size_t)(t0 + r32) * 128 + h * 16);
        ep[0] = (v4u){ew[0], ew[1], ew[2], ew[3]}; ep[1] = (v4u){ew[4], ew[5], ew[6], ew[7]};
        GAS f32x4* gp = (GAS f32x4*)(SELG + (size_t)(t0 + r32) * 128 + h * 16);
#pragma unroll
        for (int q = 0; q < 4; ++q) gp[q] = (f32x4){sc[4 * q] * rsum, sc[4 * q + 1] * rsum, sc[4 * q + 2] * rsum, sc[4 * q + 3] * rsum};
    }
}

typedef float f32x2v __attribute__((ext_vector_type(2)));
typedef _Float16 h16x2 __attribute__((ext_vector_type(2)));
typedef _Float16 h16x32 __attribute__((ext_vector_type(32)));
template <int PASS>
__device__ __forceinline__ void peer_slice_pass(Frame& F, const unsigned char* TAB, const unsigned short* SELE, const float* PW, const bf16* H2G, float* PART, const float* g2, float* OUT) {
    const int x = (int)(blockIdx.x & 7), jb = (int)(blockIdx.x >> 3), JB = (F.G - x + 7) >> 3;
    const int lane = F.lane, grp = lane >> 3, s = lane & 7;
    LAS unsigned char* wl = F.lds + F.wave * 8192;
    const LAS unsigned short* LE = (const LAS unsigned short*)wl + grp * 128; LAS float* LW = (LAS float*)(wl + 2048) + grp * 128;
    const unsigned char* tab = TAB + (size_t)x * (16384 * 192);
    const unsigned o16 = 16u * s, o8 = 16384u * 128u + 8u * s;
#define DPPF(xx, ctrl) __builtin_bit_cast(float, __builtin_amdgcn_update_dpp(0, __builtin_bit_cast(int, (xx)), (ctrl), 0xf, 0xf, true))
#define PS_ISSUE(g_, A, B, W4) do { const v2u ids_ = *(const LAS v2u*)(LE + 4 * (g_)); if (PASS == 1) W4 = *(const LAS f32x4*)(LW + 4 * (g_)); \
        const unsigned e0_ = (ids_.x & 0xffffu) * 64u, e1_ = (ids_.x >> 16) * 64u, e2_ = (ids_.y & 0xffffu) * 64u, e3_ = (ids_.y >> 16) * 64u; \
        A[0] = *(const GAS v4u*)(tab + (2u * e0_ + o16)); B[0] = *(const GAS v2u*)(tab + (e0_ + o8)); A[1] = *(const GAS v4u*)(tab + (2u * e1_ + o16)); B[1] = *(const GAS v2u*)(tab + (e1_ + o8)); \
        A[2] = *(const GAS v4u*)(tab + (2u * e2_ + o16)); B[2] = *(const GAS v2u*)(tab + (e2_ + o8)); A[3] = *(const GAS v4u*)(tab + (2u * e3_ + o16)); B[3] = *(const GAS v2u*)(tab + (e3_ + o8)); } while (0)
#pragma unroll 1
    for (int tb = jb * NWAVES + F.wave; tb < M / 8; tb += JB * NWAVES) {
        const size_t t = (size_t)tb * 8 + grp;
        { const GAS v4u* sp = (const GAS v4u*)(SELE + (size_t)tb * 1024) + lane * 2; const v4u a = sp[0], b = sp[1];
          *(LAS v4u*)(wl + lane * 32) = a; *(LAS v4u*)(wl + lane * 32 + 16) = b; }
        if (PASS == 1) { const GAS f32x4* wp = (const GAS f32x4*)(PW + (size_t)tb * 1024) + lane * 4;
#pragma unroll
            for (int q = 0; q < 4; ++q) *(LAS f32x4*)(wl + 2048 + lane * 64 + 16 * q) = wp[q]; }
        const bf16* xp = H2G + t * 2048 + 256 * x + 32 * s;
        f32x2v xv[16];
        h16x2 xh[16];
        if (PASS == 0) {
#pragma unroll
            for (int q = 0; q < 4; ++q) { const v4u w = *(const GAS v4u*)(xp + 8 * q);
                xv[4 * q] = (f32x2v){pg8::bf_lo(w.x), pg8::bf_hi(w.x)}; xv[4 * q + 1] = (f32x2v){pg8::bf_lo(w.y), pg8::bf_hi(w.y)};
                xv[4 * q + 2] = (f32x2v){pg8::bf_lo(w.z), pg8::bf_hi(w.z)}; xv[4 * q + 3] = (f32x2v){pg8::bf_lo(w.w), pg8::bf_hi(w.w)}; }
        } else {
#pragma unroll
            for (int j = 0; j < 16; ++j) { xv[j] = (f32x2v){0.f, 0.f}; xh[j] = (h16x2){(_Float16)0.f, (_Float16)0.f}; }
        }
        asm volatile("" ::: "memory");
        v4u a0[4], a1[4]; v2u b0[4], b1[4]; f32x4 w0, w1;
        PS_ISSUE(0, a0, b0, w0);
        __builtin_amdgcn_sched_barrier(0);
#pragma unroll 1
        for (int g = 0; g < 32; g += 2) {
            PS_ISSUE(g + 1, a1, b1, w1);
            __builtin_amdgcn_sched_barrier(0);
#pragma unroll
            for (int half = 0; half < 2; ++half) {
                float d[4];
#pragma unroll
                for (int i = 0; i < 4; ++i) {
                    const v4u A = half ? a1[i] : a0[i]; const v2u B = half ? b1[i] : b0[i];
                    if (PASS == 1) {
                        const h16x32 rh = __builtin_amdgcn_cvt_scalef32_pk32_f16_fp6((v6u){A.x, A.y, A.z, A.w, B.x, B.y}, 1.0f);
                        const float wf = half ? w1[i] : w0[i]; const h16x2 ww = __builtin_bit_cast(h16x2, __builtin_amdgcn_cvt_pkrtz(wf, wf));
#pragma unroll
                        for (int j = 0; j < 16; ++j) xh[j] = __builtin_elementwise_fma(ww, (h16x2){rh[2 * j], rh[2 * j + 1]}, xh[j]);
                        continue;
                    }
                    const f32x32v r = __builtin_amdgcn_cvt_scalef32_pk32_f32_fp6((v6u){A.x, A.y, A.z, A.w, B.x, B.y}, 1.0f);
                    if (PASS == 0) {
                        f32x2v p0 = (f32x2v){0.f, 0.f}, p1 = p0, p2 = p0, p3 = p0;
#pragma unroll
                        for (int j = 0; j < 16; j += 4) {
                            p0 = __builtin_elementwise_fma((f32x2v){r[2 * j], r[2 * j + 1]}, xv[j], p0); p1 = __builtin_elementwise_fma((f32x2v){r[2 * j + 2], r[2 * j + 3]}, xv[j + 1], p1);
                            p2 = __builtin_elementwise_fma((f32x2v){r[2 * j + 4], r[2 * j + 5]}, xv[j + 2], p2); p3 = __builtin_elementwise_fma((f32x2v){r[2 * j + 6], r[2 * j + 7]}, xv[j + 3], p3); }
                        const f32x2v ps = (p0 + p1) + (p2 + p3);
                        d[i] = ps.x + ps.y;
                    } else {
                        const float w = half ? w1[i] : w0[i]; const f32x2v ww = (f32x2v){w, w};
#pragma unroll
                        for (int j = 0; j < 16; ++j) xv[j] = __builtin_elementwise_fma(ww, (f32x2v){r[2 * j], r[2 * j + 1]}, xv[j]);
                    }
                }
                if (PASS == 1 && (((g + half) & 7) == 7)) {
#pragma unroll
                    for (int j = 0; j < 16; ++j) { xv[j] += (f32x2v){(float)xh[j].x, (float)xh[j].y}; xh[j] = (h16x2){(_Float16)0.f, (_Float16)0.f}; }
                }
                if (PASS == 0) {
#pragma unroll
                    for (int i = 0; i < 4; ++i) d[i] += DPPF(d[i], 0xB1);
#pragma unroll
                    for (int i = 0; i < 4; ++i) d[i] += DPPF(d[i], 0x4E);
#pragma unroll
                    for (int i = 0; i < 4; ++i) d[i] += DPPF(d[i], 0x141);
                    if (s == 0) *(LAS f32x4*)(LW + 4 * (g + half)) = (f32x4){d[0], d[1], d[2], d[3]};
                }
                if (half == 0) { __builtin_amdgcn_sched_barrier(0); PS_ISSUE((g + 2) & 31, a0, b0, w0); __builtin_amdgcn_sched_barrier(0); }
            }
        }
        asm volatile("" ::: "memory");
        if (PASS == 0) {
            GAS f32x4* pp = (GAS f32x4*)(PART + ((size_t)x * M + (size_t)tb * 8) * 128) + lane;
#pragma unroll
            for (int q = 0; q < 4; ++q) __builtin_nontemporal_store(*(const LAS f32x4*)(wl + 2048 + (q * 64 + lane) * 16), pp + q * 64);
        } else {
#pragma unroll
            for (int j = 0; j < 8; ++j) *(LAS f32x4*)(wl + lane * 128 + 16 * j) = (f32x4){xv[2 * j].x, xv[2 * j].y, xv[2 * j + 1].x, xv[2 * j + 1].y};
            asm volatile("" ::: "memory");
#pragma unroll
            for (int q = 0; q < 8; ++q) { const f32x4 a = *(const LAS f32x4*)(wl + (grp * 8 + q) * 128 + 16 * s);
                const size_t c0 = t * 2048 + 256 * x + 32 * q + 4 * s; const v2u w = *(const GAS v2u*)(H2G + c0); const f32x4 gq = *(const GAS f32x4*)(g2 + 256 * x + 32 * q + 4 * s);
                __builtin_nontemporal_store((f32x4){pg8::bf_lo(w.x) * __builtin_amdgcn_rcpf(gq[0]) + a[0], pg8::bf_hi(w.x) * __builtin_amdgcn_rcpf(gq[1]) + a[1],
                                                    pg8::bf_lo(w.y) * __builtin_amdgcn_rcpf(gq[2]) + a[2], pg8::bf_hi(w.y) * __builtin_amdgcn_rcpf(gq[3]) + a[3]}, (GAS f32x4*)(OUT + c0)); }
        }
        asm volatile("" ::: "memory");
    }
#undef PS_ISSUE
#undef DPPF
}

struct Args { const float* in[22]; float* out; unsigned char* ws; int ph_lo, ph_hi, li, pad; };
__global__ void __launch_bounds__(NWAVES * 64, 2) mk_fwd(Args args) {
    extern __shared__ __attribute__((aligned(16))) unsigned char lds[];
    Frame F;
    F.lds = (LAS unsigned char*)lds;
    F.MISC = (volatile LAS unsigned*)(F.lds + MISC_OFF);
    F.tid = threadIdx.x; F.lane = F.tid & 63; F.wave = __builtin_amdgcn_readfirstlane(F.tid >> 6);
    F.G = gridDim.x; { const int bx = blockIdx.x; F.vcu = (F.G % 8 == 0) ? (bx % 8) * (F.G / 8) + bx / 8 : bx; }
    unsigned char* ws = args.ws;
    gu32* ctl = (gu32*)(ws + WS_CTL);
    const float* x = args.in[0]; const float* meta_tok = args.in[1]; const float* g1 = args.in[2]; const float* w_in = args.in[3];
    const float* gq_da = args.in[4]; const float* gk_da = args.in[5];
    const float* lq1 = args.in[6]; const float* lk1 = args.in[7]; const float* lq2 = args.in[8]; const float* lk2 = args.in[9];
    const float* g_oda = args.in[10]; const float* gq_na = args.in[11]; const float* gk_na = args.in[12]; const float* rpb = args.in[13];
    const float* w_bda = args.in[14]; const float* w_bna = args.in[15]; const float* w_out = args.in[16]; const float* g2 = args.in[17];
    const float* w_pq = args.in[18]; const float* subk = args.in[19]; const float* pu = args.in[20]; const float* pv = args.in[21];
    float* OUT = args.out;
    bf16* WinT = (bf16*)(ws + WS_WIN_T); bf16* WbdaT = (bf16*)(ws + WS_WBDA_T); bf16* WbnaT = (bf16*)(ws + WS_WBNA_T); bf16* WoutT = (bf16*)(ws + WS_WOUT_T); bf16* WqT = (bf16*)(ws + WS_WQ_T);
    bf16* SK = (bf16*)(ws + WS_SK); bf16* XNM = (bf16*)(ws + WS_XNM); bf16* METAKV = (bf16*)(ws + WS_METAKV); float* SSP = (float*)(ws + WS_SSP);
    unsigned char* U6S = ws + WS_U6S; unsigned char* V6S = ws + WS_V6S; unsigned short* SELE = (unsigned short*)(ws + WS_SELE); float* SELG = (float*)(ws + WS_SELG); float* PW = (float*)(ws + WS_PW); float* PART = (float*)(ws + WS_PART);
    float* SCL = (float*)(ws + WS_SCL); bf16* XN = (bf16*)(ws + WS_XN); bf16* ODA = (bf16*)(ws + WS_ODA); bf16* ONA = (bf16*)(ws + WS_ONA); bf16* OC = (bf16*)(ws + WS_OC);
    bf16* QDA = (bf16*)(ws + WS_QDA); bf16* KDA = (bf16*)(ws + WS_KDA); bf16* VDA = (bf16*)(ws + WS_VDA); bf16* QNA = (bf16*)(ws + WS_QNA); bf16* KNA = (bf16*)(ws + WS_KNA); bf16* VNA = (bf16*)(ws + WS_VNA);
    bf16* Y1 = (bf16*)(ws + WS_Y1); bf16* MIX = (bf16*)(ws + WS_MIX); bf16* H2G = (bf16*)(ws + WS_H2G); bf16* PQ = (bf16*)(ws + WS_PQ);
    bf16* SGDA = (bf16*)OUT; bf16* SGNA = (bf16*)OUT + (size_t)M * 2048;

    for (int u = F.tid; u < (LDS_BYTES - LDSCTL_OFF) / 4; u += NWAVES * 64) ((LAS unsigned*)(F.lds + LDSCTL_OFF))[u] = 0u;
    __syncthreads();
    XcdBarrier bar; bar.bar = (unsigned*)(ctl + CW_BAR); bar.x = 0; bar.st = nullptr;
    if (N_LAUNCHES == 1) bar = xcd_barrier_post((unsigned*)(ctl + CW_BAR), F.MISC + 8);
#define GRID_BAR() do { if (N_LAUNCHES == 1) xcd_barrier(bar); } while (0)
    const int lo = args.ph_lo, hi = args.ph_hi;
#ifndef PH_MASK
#define PH_MASK 0x7ff
#endif
#define IN(k) (((PH_MASK >> (k)) & 1) && lo <= (k) && (k) < hi)
#define BOTH(k) (IN(k) && IN((k) + 1))

    if (IN(0)) {
        LAS float* scr = (LAS float*)(F.lds + RING_OFF + F.wave * 16384);
        const int gw = F.vcu * NWAVES + F.wave, NGW = F.G * NWAVES;
        constexpr int I_IN = (DM / 64) * (INCOLS / 32);
        for (int it = gw; it < I_IN; it += NGW) p0_transpose_item<true>(w_in, DM, INCOLS, WinT, scr, it, F.lane);
        for (int m = gw; m < M + NMETA; m += NGW) {
            if (m < M) rms_row_to_bf16(x + (size_t)m * DM, g1, XN + (size_t)m * DM, F.lane);
            else rms_row_to_bf16(meta_tok + (size_t)(m - M) * DM, g1, XNM + (size_t)(m - M) * DM, F.lane);
        }
        const size_t gtid = (size_t)F.vcu * (NWAVES * 64) + F.tid, gthreads = (size_t)F.G * (NWAVES * 64);
        for (size_t i = gtid; i < (size_t)4 * 48 * 128; i += gthreads) {
            const size_t blk = i / (48 * 128), rem = i % (48 * 128);
            *(GAS v4u*)(METAKV + blk * (64 * 1024) + rem * 8) = (v4u){0u, 0u, 0u, 0u};
        }
        if (BOTH(0)) GRID_BAR();
    }

    if (IN(1)) {
        if (F.vcu < 64) meta_proj(F, XNM, WinT, METAKV, gk_da, gk_na, F.vcu);
        pg8::Gemm g{XN, WinT, M, INCOLS, DM}; pg8::StaticOrder S; S.init(M, INCOLS, F.G, (int)blockIdx.x);
        pg8::EpiIn E{QDA, KDA, VDA, QNA, KNA, VNA, SGDA, SGNA, gq_da, gk_da, gq_na, gk_na};
        pg8::gemm_phase<pg8::EpiIn, pg8::StaticOrder, true, true>(F.lds + RING_OFF, g, S, E);
        if (BOTH(1)) GRID_BAR();
    }

    if (IN(2)) {
        const unsigned lds0 = (unsigned)(uintptr_t)lds;
        float Sb;
        { float a = __builtin_fabsf(gq_da[F.lane]), b = __builtin_fabsf(gk_da[F.lane]);
#pragma unroll
          for (int o = 1; o < 64; o <<= 1) { a = __builtin_fmaxf(a, __shfl_xor(a, o)); b = __builtin_fmaxf(b, __shfl_xor(b, o)); }
          Sb = 8.0f * a * b * 1.02f; }
        const att::DAParams DP{QDA, KDA, VDA, METAKV, METAKV + 64 * 1024, OC, Sb * LOG2E - 8.0f};
        const att::NAParams NP{QNA, KNA, VNA, METAKV + 2 * 64 * 1024, METAKV + 3 * 64 * 1024, ONA, rpb};
        volatile LAS unsigned* qslot = F.MISC + 16;
        for (;;) {
            if (F.tid == 0) *qslot = __hip_atomic_fetch_add((unsigned*)(ctl + CW_QUEUE), 1u, __ATOMIC_RELAXED, __HIP_MEMORY_SCOPE_AGENT);
            __syncthreads();
            const int u = (int)*qslot;
            __syncthreads();
            if (u >= 2048) break;
            const int grp = u >> 2, pos = u & 3;
            if (pos == 3) {
                int ln = F.lane, tdx = F.tid; asm volatile("" : "+v"(ln), "+v"(tdx));
#pragma unroll 1
                for (int i = 0; i < 8; ++i) { const int r = grp * 64 + F.wave * 8 + i, e = r >> 1, isv = r & 1;
                    fp6_row_sliced((isv ? pv : pu) + (size_t)e * 2048, isv ? V6S : U6S, e, SCL + 2 * e + isv, ln); }
                constexpr int I_B = (1024 / 64) * (DM / 32), I_O = (DM / 64) * (DM / 32);
                LAS float* scr = (LAS float*)(F.lds + RING_OFF + F.wave * 16384);
#pragma unroll 1
                for (int i = F.wave; i < 12; i += NWAVES) { int r = grp * 12 + i;
                    if (r < I_B) { p0_transpose_item<false>(w_bda, 1024, DM, WbdaT, scr, r, ln); continue; } r -= I_B;
                    if (r < I_B) { p0_transpose_item<false>(w_bna, 1024, DM, WbnaT, scr, r, ln); continue; } r -= I_B;
                    if (r < I_O) { p0_transpose_item<false>(w_out, DM, DM, WoutT, scr, r, ln); continue; } r -= I_O;
                    p0_transpose_item<false>(w_pq, DM, DM, WqT, scr, r, ln); }
                if (tdx < 8) { const size_t i = (size_t)grp * 64 + tdx * 8;
                    const f32x4 a = *(const GAS f32x4*)(subk + i), b = *(const GAS f32x4*)(subk + i + 4);
                    v4u o; o.x = pk2(a.x, a.y); o.y = pk2(a.z, a.w); o.z = pk2(b.x, b.y); o.w = pk2(b.z, b.w);
                    *(GAS v4u*)(SK + i) = o; }
                VM_WAIT(); __syncthreads();
                continue;
            }
            const int ua = 3 * grp + pos;
            if (ua < 512) {
                const int h = 7 - (ua >> 6), r = ua & 63, b = r >> 5, qb = r & 31;
                const float slope = __builtin_amdgcn_exp2f(-(float)(h + 1));
                const float Df = (2.0f * Sb + 32.0f * 0.6931472f + __logf(2.0f * (1.0f / slope + 1.0f))) / slope;
                const int D = Df > 16384.0f ? 16384 : (int)Df + 1;
                const int qlo = 16 + 256 * qb, qhi = qlo + 255;
                int Tlo = (qlo - D <= 15) ? 0 : (qlo - D - 15 + 63) / 64;
                int Thi = (qhi + D + 48) / 64; if (Thi > 128) Thi = 128;
#pragma unroll 1
                for (int c = 0; c < 2; ++c) att::da_unit((ATT_LAS char*)F.lds, lds0, DP, b, h, c, qb, Tlo, Thi);
                __syncthreads();
                { int tdx = F.tid; asm volatile("" : "+v"(tdx));
                  const int sub = tdx & 7; float lam;
                  { const int ln = tdx & 63; const float a = lq1[ln] * lk1[ln], b2 = lq2[ln] * lk2[ln]; lam = expf(wave_sum(a)) - expf(wave_sum(b2)) + 0.2f; }
#pragma unroll 1
                  for (int rr = tdx >> 3; rr < 256; rr += 64) {
                    const size_t eo = ((size_t)b * SEQ + (size_t)qb * 256 + rr) * 1024 + h * 128 + sub * 16;
                    const bf16* p0 = OC + eo; const bf16* p1 = p0 + (size_t)M * 1024;
                    const v4u a0 = *(const GAS v4u*)p0, a1 = *(const GAS v4u*)(p0 + 8), b0 = *(const GAS v4u*)p1, b1 = *(const GAS v4u*)(p1 + 8);
                    float o[16];
#define CMB(i, A, Bv) o[2 * (i)] = pg8::bf_lo(A) - lam * pg8::bf_lo(Bv); o[2 * (i) + 1] = pg8::bf_hi(A) - lam * pg8::bf_hi(Bv);
                    CMB(0, a0.x, b0.x) CMB(1, a0.y, b0.y) CMB(2, a0.z, b0.z) CMB(3, a0.w, b0.w) CMB(4, a1.x, b1.x) CMB(5, a1.y, b1.y) CMB(6, a1.z, b1.z) CMB(7, a1.w, b1.w)
#undef CMB
                    float ss = 0.f;
#pragma unroll
                    for (int i = 0; i < 16; ++i) ss += o[i] * o[i];
                    ss += __shfl_xor(ss, 1); ss += __shfl_xor(ss, 2); ss += __shfl_xor(ss, 4);
                    const float rs = __builtin_amdgcn_rsqf(ss * (1.0f / 128.0f) + EPS) * 0.8f;
                    f32x4 gv[4];
#pragma unroll
                    for (int i = 0; i < 4; ++i) gv[i] = *(const GAS f32x4*)(g_oda + sub * 16 + 4 * i);
                    v4u w0, w1;
                    w0.x = pk2(o[0] * rs * gv[0][0], o[1] * rs * gv[0][1]); w0.y = pk2(o[2] * rs * gv[0][2], o[3] * rs * gv[0][3]);
                    w0.z = pk2(o[4] * rs * gv[1][0], o[5] * rs * gv[1][1]); w0.w = pk2(o[6] * rs * gv[1][2], o[7] * rs * gv[1][3]);
                    w1.x = pk2(o[8] * rs * gv[2][0], o[9] * rs * gv[2][1]); w1.y = pk2(o[10] * rs * gv[2][2], o[11] * rs * gv[2][3]);
                    w1.z = pk2(o[12] * rs * gv[3][0], o[13] * rs * gv[3][1]); w1.w = pk2(o[14] * rs * gv[3][2], o[15] * rs * gv[3][3]);
                    *(GAS v4u*)(ODA + eo) = w0; *(GAS v4u*)(ODA + eo + 8) = w1;
                  }
                  VM_WAIT(); __syncthreads(); }
            } else {
                const int v = ua - 512, bh = v >> 5;
                att::na_unit((ATT_LAS char*)F.lds, lds0, NP, bh >> 4, bh & 15, v & 31);
            }
        }
        if (BOTH(2)) GRID_BAR();
    }


    if (IN(4)) {
        { pg8::Gemm g{ODA, WbdaT, M, DM, 1024}; pg8::StaticOrder S; S.init(M, DM, F.G, (int)blockIdx.x);
          pg8::EpiGate<0> E{SGDA, nullptr, Y1};
          pg8::gemm_phase<pg8::EpiGate<0>, pg8::StaticOrder, true, true>(F.lds + RING_OFF, g, S, E); }
        VM_WAIT(); __syncthreads();
        { pg8::Gemm g{ONA, WbnaT, M, DM, 1024}; pg8::StaticOrder S; S.init(M, DM, F.G, (int)blockIdx.x);
          pg8::EpiGate<1> E{SGNA, Y1, MIX};
          pg8::gemm_phase<pg8::EpiGate<1>, pg8::StaticOrder, true, true>(F.lds + RING_OFF, g, S, E); }
        if (BOTH(4)) GRID_BAR();
    }

    if (IN(5)) {
        pg8::Gemm g{MIX, WoutT, M, DM, DM}; pg8::StaticOrder S; S.init(M, DM, F.G, (int)blockIdx.x);
        pg8::EpiOut E{x, OUT, H2G, g2, SSP};
        pg8::gemm_phase<pg8::EpiOut, pg8::StaticOrder, true, true>(F.lds + RING_OFF, g, S, E);
        if (BOTH(5)) GRID_BAR();
    }

    if (IN(6)) {
        pg8::Gemm g{H2G, WqT, M, DM, DM}; pg8::StaticOrder S; S.init(M, DM, F.G, (int)blockIdx.x);
        pg8::EpiPQ E{PQ, SSP};
        pg8::gemm_phase<pg8::EpiPQ, pg8::StaticOrder, true, true>(F.lds + RING_OFF, g, S, E);
        if (BOTH(6)) GRID_BAR();
    }

    if (IN(7)) {
#pragma unroll 1
        for (int tile = (int)blockIdx.x; tile < M / PEER_TOK; tile += F.G) peer_retrieve(F, PQ, SK, SELE, SELG, tile);
        if (BOTH(7)) GRID_BAR();
    }
    if (IN(8)) {
        peer_slice_pass<0>(F, U6S, SELE, nullptr, H2G, PART, g2, OUT);
        if (BOTH(8)) GRID_BAR();
    }
    if (IN(9)) {
        for (size_t idx = (size_t)blockIdx.x * (NWAVES * 64) + F.tid; idx < (size_t)M * 32; idx += (size_t)F.G * (NWAVES * 64)) {
            const size_t t = idx >> 5; const int k4 = (int)(idx & 31) * 4;
            f32x4 sum = *(const GAS f32x4*)(PART + t * 128 + k4);
#pragma unroll
            for (int xs = 1; xs < 8; ++xs) sum += *(const GAS f32x4*)(PART + ((size_t)xs * M + t) * 128 + k4);
            const float rstd = pg8::row_rstd(SSP, (int)t);
            const v2u ids = *(const GAS v2u*)(SELE + t * 128 + k4); const f32x4 gt = *(const GAS f32x4*)(SELG + t * 128 + k4);
            const unsigned e[4] = {ids.x & 0xffffu, ids.x >> 16, ids.y & 0xffffu, ids.y >> 16};
            f32x4 w;
#pragma unroll
            for (int c = 0; c < 4; ++c) { const f32x2 sc = *(const GAS f32x2*)(SCL + 2 * e[c]); w[c] = gt[c] * gelu_tanh(sum[c] * (rstd * sc[0])) * sc[1]; }
            *(GAS f32x4*)(PW + t * 128 + k4) = w;
        }
        if (BOTH(9)) GRID_BAR();
    }
    if (IN(10)) {
        peer_slice_pass<1>(F, V6S, SELE, PW, H2G, nullptr, g2, OUT);
    }
#undef IN
#undef BOTH
}

extern "C" void kernel_launch(void* const* d_in, const int* in_sizes, int n_in, void* d_out, int out_size, void* d_ws, size_t ws_size, hipStream_t stream) {
    static int grid = 0;
    if (grid == 0) {
        if (n_in != 22 || in_sizes[0] != M * DM || out_size != M * DM || ws_size < WS_END) { fprintf(stderr, "kernel_launch: unexpected shapes (n_in %d, in0 %d, out %d, ws %zu); nothing launched\n", n_in, n_in > 0 ? in_sizes[0] : -1, out_size, ws_size); grid = -1; return; }
        int dev = 0, cus = 0, per_cu = 0;
        if (hipGetDevice(&dev) != hipSuccess || hipDeviceGetAttribute(&cus, hipDeviceAttributeMultiprocessorCount, dev) != hipSuccess) { grid = -1; return; }
        if (hipFuncSetAttribute((const void*)mk_fwd, hipFuncAttributeMaxDynamicSharedMemorySize, LDS_BYTES) != hipSuccess) { fprintf(stderr, "kernel_launch: hipFuncSetAttribute failed\n"); grid = -1; return; }
        if (hipOccupancyMaxActiveBlocksPerMultiprocessor(&per_cu, (const void*)mk_fwd, NWAVES * 64, LDS_BYTES) != hipSuccess || per_cu < 1)
            fprintf(stderr, "kernel_launch: note: occupancy query reports %d workgroups per CU\n", per_cu);
        (void)hipGetLastError();
        grid = cus;
    }
    if (grid < 0) return;
    if (hipMemsetAsync((char*)d_ws + WS_CTL, 0, CTL_ZERO_BYTES, stream) != hipSuccess) return;
    Args a{};
    for (int i = 0; i < 22; ++i) a.in[i] = (const float*)d_in[i];
    a.out = (float*)d_out; a.ws = (unsigned char*)d_ws;
    if (N_LAUNCHES == 1) { a.ph_lo = 0; a.ph_hi = N_PHASES; a.li = 0; hipLaunchKernelGGL(mk_fwd, dim3(grid), dim3(NWAVES * 64), LDS_BYTES, stream, a); }
    else for (int li = 0; li < N_PHASES; ++li) { a.ph_lo = li; a.ph_hi = li + 1; a.li = li; hipLaunchKernelGGL(mk_fwd, dim3(grid), dim3(NWAVES * 64), LDS_BYTES, stream, a); }
}
```
